# Optimizing an MI355X kernel written in HIP

```python
import jax, jax.numpy as jnp
from jax import lax
import numpy as np

D_MODEL = 1024
BATCH = 8
SEQ = 4096
DEPTH = 1

HG_HEADS = 8
HG_DK = 128
HG_DV = D_MODEL // HG_HEADS
HG_CHUNK = 64
RET_HEADS = 8
RET_DV = D_MODEL // RET_HEADS
RET_DK = RET_DV // 2
RET_CHUNK = 128
ROPE_BASE = 10000.0
EPS = 1e-6

HG_Q = HG_HEADS * HG_DK
HG_V = HG_HEADS * HG_DV
RET_Q = RET_HEADS * RET_DK
RET_V = RET_HEADS * RET_DV
SPLITS = [HG_Q, HG_Q, HG_V, HG_V, RET_Q, RET_Q, RET_V, RET_V, D_MODEL, D_MODEL]
D_IN = sum(SPLITS)

kernel_name = "hybrid_hgrn2_retention_gated_block"


def rms_norm(x, g):
    xf = x.astype(jnp.float32)
    y = xf * lax.rsqrt(jnp.mean(xf * xf, axis=-1, keepdims=True) + EPS)
    return (y * g.astype(jnp.float32)).astype(x.dtype)


def head_rms_norm(o, g):
    H, d = o.shape[-2], o.shape[-1]
    y = o * lax.rsqrt(jnp.mean(o * o, axis=-1, keepdims=True) + EPS)
    y = y * g.astype(jnp.float32).reshape(H, d)
    return y.reshape(o.shape[0], o.shape[1], H * d)


def rotary(t, pos):
    dk = t.shape[-1]
    inv_freq = 1.0 / (ROPE_BASE ** jnp.linspace(0.0, 1.0, dk // 2, dtype=jnp.float32))
    ang = pos.astype(jnp.float32)[:, None] * inv_freq[None, :]
    cos = jnp.cos(ang)[None, :, None, :]
    sin = jnp.sin(ang)[None, :, None, :]
    t1, t2 = t[..., : dk // 2], t[..., dk // 2:]
    return jnp.concatenate([t1 * cos - t2 * sin, t1 * sin + t2 * cos], axis=-1)


def hgrn2_chunkwise(q, fpre, v, lb):
    B, L, H, dk = q.shape
    dv = v.shape[-1]
    C = HG_CHUNK
    N = L // C
    q = jax.nn.silu(q)
    lbh = lb.astype(jnp.float32).reshape(H, dk)
    f = lbh + (1.0 - lbh) * jax.nn.sigmoid(fpre)
    k = 1.0 - f
    logf = jnp.log(f)

    def to_chunks(t):
        return t.reshape(B, N, C, H, t.shape[-1]).transpose(1, 0, 3, 2, 4)

    mask = jnp.tril(jnp.ones((C, C), dtype=bool))[:, :, None]

    def step(S, inp):
        qc, kc, lfc, vc = inp
        b = jnp.cumsum(lfc, axis=2)
        inter = jnp.einsum('bhtd,bhde->bhte', qc * jnp.exp(b), S)
        diff = b[:, :, :, None, :] - b[:, :, None, :, :]
        decay = jnp.exp(jnp.where(mask, diff, -jnp.inf))
        A = jnp.einsum('bhtsd,bhsd->bhts', qc[:, :, :, None, :] * decay, kc)
        intra = jnp.einsum('bhts,bhse->bhte', A, vc)
        b_last = b[:, :, -1:, :]
        S_new = jnp.exp(b_last[:, :, 0, :])[..., None] * S + jnp.einsum(
            'bhsd,bhse->bhde', kc * jnp.exp(b_last - b), vc)
        return S_new, inter + intra

    S0 = jnp.zeros((B, H, dk, dv), jnp.float32)
    _, o = lax.scan(step, S0, (to_chunks(q), to_chunks(k), to_chunks(logf), to_chunks(v)))
    return o.transpose(1, 0, 3, 2, 4).reshape(B, L, H, dv)


def retention_chunkwise(q, k, v):
    B, L, H, dk = q.shape
    dv = v.shape[-1]
    C = RET_CHUNK
    N = L // C
    log_gamma = jnp.log(1.0 - jnp.exp2(-5.0 - jnp.arange(H, dtype=jnp.float32)))
    k = k * (dk ** -0.5)
    qc = q.reshape(B, N, C, H, dk).transpose(0, 3, 1, 2, 4)
    kc = k.reshape(B, N, C, H, dk).transpose(0, 3, 1, 2, 4)
    vc = v.reshape(B, N, C, H, dv).transpose(0, 3, 1, 2, 4)
    idx = jnp.arange(C, dtype=jnp.float32)
    rel = idx[:, None] - idx[None, :]
    Dm = jnp.where(rel >= 0, jnp.exp(log_gamma[:, None, None] * jnp.maximum(rel, 0.0)), 0.0)
    scores = jnp.einsum('bhnid,bhnjd->bhnij', qc, kc) * Dm[:, None]
    intra = jnp.einsum('bhnij,bhnje->bhnie', scores, vc)
    zeta = jnp.exp(log_gamma[:, None] * (C - 1.0 - idx))
    chunk_state = jnp.einsum('bhnjd,bhnje->bhnde', kc * zeta[:, None, :, None], vc)
    chunk_decay = jnp.exp(log_gamma * C)[None, :, None, None]

    def step(R, s):
        return chunk_decay * R + s, R

    R0 = jnp.zeros((B, H, dk, dv), jnp.float32)
    _, R_prev = lax.scan(step, R0, chunk_state.transpose(2, 0, 1, 3, 4))
    R_prev = R_prev.transpose(1, 2, 0, 3, 4)
    xi = jnp.exp(log_gamma[:, None] * (idx + 1.0))
    cross = jnp.einsum('bhnid,bhnde->bhnie', qc * xi[:, None, :, None], R_prev)
    return (intra + cross).transpose(0, 2, 3, 1, 4).reshape(B, L, H, dv)


def setup_inputs(seed: int = 0) -> dict:
    key = jax.random.key(seed)
    ks = jax.random.split(key, 12)
    f32 = jnp.float32
    x = jax.random.normal(ks[0], (BATCH, SEQ, D_MODEL), f32)
    c = jax.random.normal(ks[1], (BATCH, D_MODEL), f32)
    norm_g = 1.0 + 0.05 * jax.random.normal(ks[2], (DEPTH, D_MODEL), f32)
    w_ada = 0.5 * D_MODEL ** -0.5 * jax.random.normal(ks[3], (DEPTH, D_MODEL, 3 * D_MODEL), f32)
    b_ada = 0.02 * jax.random.normal(ks[4], (DEPTH, 3 * D_MODEL), f32)
    w_in = D_MODEL ** -0.5 * jax.random.normal(ks[5], (DEPTH, D_MODEL, D_IN), f32)
    hg_lb_logits = 0.5 * jax.random.normal(ks[6], (DEPTH + 1, HG_Q), f32)
    hg_norm_g = 1.0 + 0.05 * jax.random.normal(ks[7], (DEPTH, HG_V), f32)
    ret_norm_g = 1.0 + 0.05 * jax.random.normal(ks[8], (DEPTH, RET_V), f32)
    w_out = D_MODEL ** -0.5 * jax.random.normal(ks[9], (DEPTH, D_MODEL, D_MODEL), f32)
    final_g = 1.0 + 0.05 * jax.random.normal(ks[10], (D_MODEL,), f32)
    return {"x": x, "c": c, "norm_g": norm_g, "w_ada": w_ada, "b_ada": b_ada,
            "w_in": w_in, "hg_lb_logits": hg_lb_logits, "hg_norm_g": hg_norm_g,
            "ret_norm_g": ret_norm_g, "w_out": w_out, "final_g": final_g}


def reference(x, c, norm_g, w_ada, b_ada, w_in, hg_lb_logits, hg_norm_g, ret_norm_g, w_out, final_g):
    B, L, D = x.shape
    pos = jnp.arange(L, dtype=jnp.int32)
    lower_bounds = jnp.cumsum(jax.nn.softmax(hg_lb_logits.astype(jnp.float32), axis=0), axis=0)
    offsets = np.cumsum([0] + SPLITS)[1:-1].tolist()
    for layer in range(DEPTH):
        mod = jax.nn.silu(c) @ w_ada[layer] + b_ada[layer]
        shift, scale, gate = jnp.split(mod[:, None, :], 3, axis=-1)
        h = rms_norm(x, norm_g[layer]) * (1.0 + scale) + shift
        proj = h @ w_in[layer]
        (hq, hf, hi, hz, rq, rk, rv, rz, ga, gb) = jnp.split(proj, offsets, axis=-1)
        f32 = jnp.float32
        oA = hgrn2_chunkwise(hq.astype(f32).reshape(B, L, HG_HEADS, HG_DK),
                             hf.astype(f32).reshape(B, L, HG_HEADS, HG_DK),
                             hi.astype(f32).reshape(B, L, HG_HEADS, HG_DV),
                             lower_bounds[layer])
        uA = head_rms_norm(oA, hg_norm_g[layer]) * jax.nn.silu(hz.astype(f32))
        qB = rotary(rq.astype(f32).reshape(B, L, RET_HEADS, RET_DK), pos)
        kB = rotary(rk.astype(f32).reshape(B, L, RET_HEADS, RET_DK), pos)
        oB = retention_chunkwise(qB, kB, rv.astype(f32).reshape(B, L, RET_HEADS, RET_DV))
        uB = head_rms_norm(oB, ret_norm_g[layer]) * jax.nn.silu(rz.astype(f32))
        m = (jax.nn.sigmoid(ga.astype(f32)) * uA + jax.nn.sigmoid(gb.astype(f32)) * uB).astype(x.dtype)
        x = x + gate * (m @ w_out[layer])
    return rms_norm(x, final_g)
```

```cpp
#include <hip/hip_runtime.h>
#include <hip/hip_cooperative_groups.h>
#include <cstdio>
namespace cg = cooperative_groups;
namespace pg8 {
#define PG8_LAS __attribute__((address_space(3)))
typedef unsigned short bf16_t;
typedef short bf16x8 __attribute__((ext_vector_type(8)));
typedef float f32x4 __attribute__((ext_vector_type(4)));
typedef unsigned u32x4 __attribute__((ext_vector_type(4)));
constexpr int BM = 256, BK = 64, HALF = 128, HTB = HALF * BK * 2  , STAGE_BYTES = 8 * HTB, NXCD = 8, WGM = 8;

__host__ __device__ __forceinline__ int lds_byte(int r, int c) { const int st = (r >> 4) * 2 + (c >> 5), rr = r & 15, cc = c & 31, ob = rr * 64 + cc * 2; return st * 1024 + (ob ^ (((ob >> 9) & 1) << 5)); }
__host__ __device__ __forceinline__ void stage_rc(int b, int& R, int& C) { const int st = b / 1024, sb = b % 1024, swz = sb ^ (((sb >> 9) & 1) << 5); R = (st >> 1) * 16 + swz / 64; C = (st & 1) * 32 + (swz % 64) / 2; }
__host__ __device__ __forceinline__ int perm32(int rho) { const int n = rho >> 4, i = rho & 15; return 8 * (i >> 2) + 4 * n + (i & 3); }

struct Unit { int pm, pn; };
struct Gemm { const bf16_t* A; const bf16_t* Bt; int M, N, K; };
struct StaticOrder {
    int nM, nN, nwg, G, c;
    __host__ __device__ void init(int M, int N, int G_, int c_) { nM = M / BM; nN = N / BM; nwg = nM * nN; G = G_; c = c_; }
    __host__ __device__ bool next(int i, Unit& u) const {
        const long L = (long)i * G + c; if (L >= nwg) return false;
        int wgid = (int)L; { const int q = nwg / NXCD, r = nwg % NXCD, xcd = wgid % NXCD, off = wgid / NXCD; wgid = (xcd < r ? xcd * (q + 1) : r * (q + 1) + (xcd - r) * q) + off; }
        const int nig = WGM * nN, gid = wgid / nig, fm = gid * WGM, gsz = (nM - fm) < WGM ? (nM - fm) : WGM;
        u.pm = fm + ((wgid % nig) % gsz); u.pn = (wgid % nig) / gsz; return true;
    }
    __device__ __forceinline__ void a_ready(const Unit&) const {}
    __device__ __forceinline__ void done(const Unit&) const {}
};
__device__ __forceinline__ unsigned cvt_pk_bf16(float lo, float hi) { unsigned r; asm volatile("v_cvt_pk_bf16_f32 %0, %1, %2" : "=v"(r) : "v"(lo), "v"(hi)); return r; }
typedef float f32x2 __attribute__((ext_vector_type(2)));
template <class Epi, class Sched, bool STAMP = false>
__device__ __forceinline__ void gemm_phase(PG8_LAS unsigned char* lds, const Gemm g, const Sched& S, const Epi& E, unsigned long long* stamps) {
    int tid_ = threadIdx.x; asm volatile("" : "+v"(tid_)); const int tid = tid_, wid = __builtin_amdgcn_readfirstlane(tid >> 6), lane = tid & 63, wr = wid >> 2, wc = wid & 3, fr = lane & 15, fq = lane >> 4;
    const int K = g.K, nt = K / BK;
    int ts_lo = 0, ts_hi = 0, nts = 0; const unsigned long long rt_entry = STAMP ? (unsigned long long)wall_clock64() : 0ull;
#define PG8_STAMP() do { if (STAMP && wid == 0 && nts < 64) { const unsigned long long _c = (unsigned long long)clock64(); \
        ts_lo = (lane == nts) ? (int)(unsigned)_c : ts_lo; ts_hi = (lane == nts) ? (int)(unsigned)(_c >> 32) : ts_hi; ++nts; } } while (0)
    PG8_STAMP();
    unsigned voffA[2], voffB[2];
#pragma unroll
    for (int i = 0; i < 2; ++i) { int R, C; stage_rc(tid * 16 + i * 8192, R, C); const int Rb = Epi::PERM ? ((R & ~31) + perm32(R & 31)) : R;
        voffA[i] = (unsigned)(R * K + C) * 2u; voffB[i] = (unsigned)(Rb * K + C) * 2u; }
    const size_t kstep = (size_t)(BK * 2);
    const size_t hstep = (size_t)HALF * K * 2;
    const size_t tstep = 2 * hstep;
    const unsigned ldsw = (unsigned)wid * 1024u;
    const int aoff = lds_byte(wr * 64 + fr, fq * 8), boff = lds_byte(wc * 32 + fr, fq * 8);
#define PG8_SA(b, h) (((b) * 2 + (h)) * HTB)
#define PG8_SB(b, h) ((4 + (b) * 2 + (h)) * HTB)
#define PG8_STAGE(bufoff, gbase, voff) do { _Pragma("unroll") for (int _i = 0; _i < 2; ++_i) \
        __builtin_amdgcn_global_load_lds((const unsigned*)((const char*)(gbase) + (voff)[_i]), (PG8_LAS unsigned*)(lds + (bufoff) + ldsw + _i * 8192), 16, 0, 0); } while (0)
#define PG8_LDA(dst, b, h) do { _Pragma("unroll") for (int m = 0; m < 4; ++m) _Pragma("unroll") for (int k = 0; k < 2; ++k) dst[m][k] = *(const PG8_LAS bf16x8*)(lds + PG8_SA(b, h) + aoff + m * 2048 + k * 1024); } while (0)
#define PG8_LDB(dst, b, h) do { _Pragma("unroll") for (int n = 0; n < 2; ++n) _Pragma("unroll") for (int k = 0; k < 2; ++k) dst[n][k] = *(const PG8_LAS bf16x8*)(lds + PG8_SB(b, h) + boff + n * 2048 + k * 1024); } while (0)
#define PG8_MMA(ai, bj, At, Bt) do { __builtin_amdgcn_s_setprio(1); _Pragma("unroll") for (int m = 0; m < 4; ++m) _Pragma("unroll") for (int n = 0; n < 2; ++n) _Pragma("unroll") for (int k = 0; k < 2; ++k) \
        acc[ai][bj][m][n] = __builtin_amdgcn_mfma_f32_16x16x32_bf16(Bt[n][k], At[m][k], acc[ai][bj][m][n], 0, 0, 0); __builtin_amdgcn_s_setprio(0); } while (0)
#define PG8_WAIT_V(n) asm volatile("s_waitcnt vmcnt(" #n ")" ::: "memory")
#define PG8_WAIT_L(n) asm volatile("s_waitcnt lgkmcnt(" #n ")" ::: "memory")
#define PG8_BAR __builtin_amdgcn_s_barrier()
#define PG8_SCHED __builtin_amdgcn_sched_barrier(0)
    Unit cur, nxt; int ui = 0;
    if (!S.next(0, cur)) return;
    f32x4 acc[2][2][4][2];
#pragma unroll
    for (int a = 0; a < 2; ++a)
#pragma unroll
        for (int b = 0; b < 2; ++b)
#pragma unroll
            for (int m = 0; m < 4; ++m)
#pragma unroll
                for (int n = 0; n < 2; ++n) acc[a][b][m][n] = (f32x4){0.f, 0.f, 0.f, 0.f};
    bf16x8 At[4][2], B0[2][2], B1[2][2];
    const char* cA = (const char*)g.A + (size_t)cur.pm * tstep; const char* cB = (const char*)g.Bt + (size_t)cur.pn * tstep;
    S.a_ready(cur);
    PG8_STAGE(PG8_SB(0, 0), cB, voffB); PG8_STAGE(PG8_SA(0, 0), cA, voffA); PG8_STAGE(PG8_SB(0, 1), cB + hstep, voffB); PG8_STAGE(PG8_SA(0, 1), cA + hstep, voffA);
    if (wr == 1) PG8_BAR;
    PG8_WAIT_V(4); PG8_BAR;
    PG8_STAGE(PG8_SB(1, 0), cB + kstep, voffB); PG8_STAGE(PG8_SA(1, 0), cA + kstep, voffA); PG8_STAGE(PG8_SB(1, 1), cB + hstep + kstep, voffB);
    PG8_WAIT_V(6); PG8_BAR;
    PG8_STAMP();
    for (;;) {
        const bool has_next = S.next(ui + 1, nxt);
        const char* nA = has_next ? (const char*)g.A + (size_t)nxt.pm * tstep : cA; const char* nB = has_next ? (const char*)g.Bt + (size_t)nxt.pn * tstep : cB;
        for (int t = 0; t < nt; t += 2) {
            const bool last = (t == nt - 2);
            const char* a1 = cA + (size_t)(t + 1) * kstep;
            const char* a2 = last ? nA : cA + (size_t)(t + 2) * kstep; const char* b2 = last ? nB : cB + (size_t)(t + 2) * kstep;
            const char* a3 = a2 + kstep; const char* b3 = b2 + kstep;
            if (last && has_next) S.a_ready(nxt);
            PG8_LDB(B0, 0, 0); PG8_SCHED; PG8_LDA(At, 0, 0); PG8_STAGE(PG8_SA(1, 1), a1 + hstep, voffA);
            PG8_WAIT_L(8); PG8_BAR; PG8_WAIT_L(0); PG8_MMA(0, 0, At, B0); PG8_BAR; PG8_SCHED;
            PG8_LDB(B1, 0, 1); PG8_STAGE(PG8_SB(0, 0), b2, voffB);
            PG8_BAR; PG8_WAIT_L(0); PG8_MMA(0, 1, At, B1); PG8_BAR;
            PG8_LDA(At, 0, 1); PG8_STAGE(PG8_SA(0, 0), a2, voffA);
            PG8_BAR; PG8_WAIT_L(0); PG8_MMA(1, 0, At, B0); PG8_BAR; PG8_SCHED;
            PG8_STAGE(PG8_SB(0, 1), b2 + hstep, voffB);
            PG8_WAIT_V(6); PG8_BAR; PG8_MMA(1, 1, At, B1); PG8_BAR;
            PG8_LDB(B0, 1, 0); PG8_SCHED; PG8_LDA(At, 1, 0); PG8_STAGE(PG8_SA(0, 1), a2 + hstep, voffA);
            PG8_WAIT_L(8); PG8_BAR; PG8_WAIT_L(0); PG8_MMA(0, 0, At, B0); PG8_BAR; PG8_SCHED;
            PG8_LDB(B1, 1, 1); PG8_STAGE(PG8_SB(1, 0), b3, voffB);
            PG8_BAR; PG8_WAIT_L(0); PG8_MMA(0, 1, At, B1); PG8_BAR;
            PG8_LDA(At, 1, 1); PG8_STAGE(PG8_SA(1, 0), a3, voffA);
            PG8_BAR; PG8_WAIT_L(0); PG8_MMA(1, 0, At, B0); PG8_BAR; PG8_SCHED;
            PG8_STAGE(PG8_SB(1, 1), b3 + hstep, voffB);
            PG8_WAIT_V(6); PG8_BAR; PG8_MMA(1, 1, At, B1); PG8_BAR;
        }
        PG8_STAMP();
        if constexpr (!Epi::AFTER_DRAIN) { E(acc, cur, wr, wc, fr, fq); S.done(cur); }
        PG8_STAMP();
        if (!has_next) break;
#pragma unroll
        for (int a = 0; a < 2; ++a)
#pragma unroll
            for (int b = 0; b < 2; ++b)
#pragma unroll
                for (int m = 0; m < 4; ++m)
#pragma unroll
                    for (int n = 0; n < 2; ++n) acc[a][b][m][n] = (f32x4){0.f, 0.f, 0.f, 0.f};
        cur = nxt; cA = nA; cB = nB; ++ui;
    }
    PG8_WAIT_V(0);
    if (wr == 0) PG8_BAR;
    PG8_BAR;
    if constexpr (Epi::AFTER_DRAIN) { E.fused(acc, cur, wr, wc, fr, fq, lds, wid, lane); S.done(cur); }
    PG8_STAMP();
    if (STAMP && wid == 0) { stamps[lane] = lane < nts ? (((unsigned long long)(unsigned)ts_hi << 32) | (unsigned)ts_lo) : 0ull;
        if (lane == 62) stamps[62] = rt_entry; if (lane == 63) stamps[63] = (unsigned long long)wall_clock64(); }
#undef PG8_STAMP
#undef PG8_SA
#undef PG8_SB
#undef PG8_STAGE
#undef PG8_LDA
#undef PG8_LDB
#undef PG8_MMA
#undef PG8_WAIT_V
#undef PG8_WAIT_L
#undef PG8_BAR
#undef PG8_SCHED
}
}

using pg8::bf16_t; using pg8::bf16x8; using pg8::f32x4; using pg8::u32x4; using pg8::Unit;
#define LAS __attribute__((address_space(3)))
typedef LAS unsigned char* ldsp;
typedef unsigned u32x2 __attribute__((ext_vector_type(2)));
typedef float f32x2v __attribute__((ext_vector_type(2)));

constexpr int D = 1024, NB = 8, SEQ = 4096, MTOT = NB * SEQ, DIN = 9216;
constexpr int MH = MTOT / 2;
constexpr float EPS = 1e-6f;
constexpr int C_HQ = 0, C_HF = 1024, C_HI = 2048, C_HZ = 3072, C_RQ = 4096, C_RK = 4608, C_RV = 5120, C_RZ = 6144, C_GA = 7168, C_GB = 8192;
constexpr int NSEG = 8, SEGLEN = 512, NCH = SEGLEN / 64;
constexpr size_t MiB = 1u << 20;
constexpr size_t WS_MOD = 0, WS_LB = 131072, WS_ROPE = 262144, WS_WIN = 2 * MiB, WS_WOUT = 20 * MiB, WS_SLA = 22 * MiB, WS_SLB = 38 * MiB, WS_DA = 46 * MiB,
                 WS_H = 48 * MiB, WS_PROJ = 112 * MiB, WS_END = 400 * MiB;
constexpr int L_QT = 0, L_KT = 17408, L_KTT = 34816, L_VT = 53248, L_SM = 71680, L_AM = 106496, L_OF = 115712, L_SUB = 149504, L_EM = 153600, LDS_BYTES = 154624;
constexpr int RS_D = 272, RS_S = 144, RS_O = 528;

__device__ __forceinline__ unsigned pkbf(float lo, float hi) { return pg8::cvt_pk_bf16(lo, hi); }
__device__ __forceinline__ float bflo(unsigned w) { return __uint_as_float(w << 16); }
__device__ __forceinline__ float bfhi(unsigned w) { return __uint_as_float(w & 0xffff0000u); }
__device__ __forceinline__ float sigm(float x) { return 1.0f / (1.0f + __expf(-x)); }
__device__ __forceinline__ float silu(float x) { return x / (1.0f + __expf(-x)); }

struct EpiProj {
    static constexpr bool PERM = true, AFTER_DRAIN = false;
    bf16_t* O; const float* lb; const float* rope;
    __device__ __forceinline__ void operator()(const f32x4 (&acc)[2][2][4][2], const Unit& u, int wr, int wc, int fr, int fq) const {
        const int pn = u.pn;
        const int mode = pn < 4 ? 1 : pn < 8 ? 2 : pn < 12 ? 0 : pn < 16 ? 1 : pn < 18 ? 3 : pn < 20 ? 4 : pn < 24 ? 0 : pn < 28 ? 1 : 5;
        const int row0 = u.pm * 256 + wr * 64 + fr;
        const int col0 = pn * 256 + wc * 32 + 8 * fq;
        f32x4 lbv[2][2];
#pragma unroll
        for (int bj = 0; bj < 2; ++bj)
#pragma unroll
            for (int n = 0; n < 2; ++n) lbv[bj][n] = (mode == 2) ? *(const f32x4*)(lb + (col0 - C_HF) + bj * 128 + 4 * n) : (f32x4){0.f, 0.f, 0.f, 0.f};
#pragma unroll
        for (int ai = 0; ai < 2; ++ai)
#pragma unroll
            for (int m = 0; m < 4; ++m) {
                const int row = row0 + ai * 128 + m * 16;
                bf16_t* rowp = O + (size_t)row * DIN + col0;
                f32x4 cs0 = (f32x4){1.f, 0.f, 1.f, 0.f}, cs1 = cs0;
                if (mode == 3 || mode == 4) { const float* rp = rope + ((size_t)(row & (SEQ - 1)) * 32 + ((col0 & 63) >> 1)) * 2; cs0 = *(const f32x4*)rp; cs1 = *(const f32x4*)(rp + 4); }
#pragma unroll
                for (int bj = 0; bj < 2; ++bj) {
                    f32x4 v0 = acc[ai][bj][m][0], v1 = acc[ai][bj][m][1];
                    if (mode == 1) {
#pragma unroll
                        for (int j = 0; j < 4; ++j) { v0[j] = silu(v0[j]); v1[j] = silu(v1[j]); }
                    } else if (mode == 5) {
#pragma unroll
                        for (int j = 0; j < 4; ++j) { v0[j] = sigm(v0[j]); v1[j] = sigm(v1[j]); }
                    } else if (mode == 2) {
#pragma unroll
                        for (int j = 0; j < 4; ++j) { const float l0 = lbv[bj][0][j], l1 = lbv[bj][1][j];
                            v0[j] = __logf(l0 + (1.0f - l0) * sigm(v0[j])); v1[j] = __logf(l1 + (1.0f - l1) * sigm(v1[j])); }
                    } else if (mode == 3 || mode == 4) {
                        const float sc = (mode == 4) ? 0.125f : 1.0f;
                        f32x4 r0, r1;
                        r0[0] = (v0[0] * cs0[0] - v0[1] * cs0[1]) * sc; r0[1] = (v0[0] * cs0[1] + v0[1] * cs0[0]) * sc;
                        r0[2] = (v0[2] * cs0[2] - v0[3] * cs0[3]) * sc; r0[3] = (v0[2] * cs0[3] + v0[3] * cs0[2]) * sc;
                        r1[0] = (v1[0] * cs1[0] - v1[1] * cs1[1]) * sc; r1[1] = (v1[0] * cs1[1] + v1[1] * cs1[0]) * sc;
                        r1[2] = (v1[2] * cs1[2] - v1[3] * cs1[3]) * sc; r1[3] = (v1[2] * cs1[3] + v1[3] * cs1[2]) * sc;
                        v0 = r0; v1 = r1;
                    }
                    u32x4 w; w.x = pkbf(v0[0], v0[1]); w.y = pkbf(v0[2], v0[3]); w.z = pkbf(v1[0], v1[1]); w.w = pkbf(v1[2], v1[3]);
                    *(u32x4*)(rowp + bj * 128) = w;
                }
            }
    }
};
struct EpiRes {
    static constexpr bool PERM = false, AFTER_DRAIN = false;
    const float* x; float* out; const float* mod;
    __device__ __forceinline__ void operator()(const f32x4 (&acc)[2][2][4][2], const Unit& u, int wr, int wc, int fr, int fq) const {
        const int row0 = u.pm * 256 + wr * 64 + fr, col0 = u.pn * 256 + wc * 32 + 4 * fq;
        const int b = (u.pm * 256) / SEQ;
        const float* gate = mod + (size_t)b * 3 * D + 2 * D + col0;
        f32x4 gv[2][2];
#pragma unroll
        for (int bj = 0; bj < 2; ++bj)
#pragma unroll
            for (int n = 0; n < 2; ++n) gv[bj][n] = *(const f32x4*)(gate + bj * 128 + n * 16);
#pragma unroll
        for (int ai = 0; ai < 2; ++ai)
#pragma unroll
            for (int m = 0; m < 4; ++m) { const size_t off = (size_t)(row0 + ai * 128 + m * 16) * D + col0;
#pragma unroll
                for (int bj = 0; bj < 2; ++bj)
#pragma unroll
                    for (int n = 0; n < 2; ++n) { const f32x4 xs = *(const f32x4*)(x + off + bj * 128 + n * 16); *(f32x4*)(out + off + bj * 128 + n * 16) = xs + gv[bj][n] * acc[ai][bj][m][n]; }
                asm volatile("" ::: "memory"); }
    }
};

struct Params { const float* x; const float* c; const float* norm_g; const float* w_ada; const float* b_ada; const float* w_in; const float* lb_logits; const float* hg_norm_g;
                const float* ret_norm_g; const float* w_out; const float* final_g; float* out; unsigned char* ws; };

__device__ __forceinline__ void p0_mod(ldsp lds, const Params& p, int job) {
    const int tid = threadIdx.x, cl = tid & 63, ks = tid >> 6, n = job * 64 + cl;
    LAS float* sc = (LAS float*)lds;
    LAS float* red = (LAS float*)(lds + 32768);
    for (int i = tid; i < NB * D; i += 512) sc[i] = silu(p.c[i]);
    __syncthreads();
    float a[NB];
#pragma unroll
    for (int b = 0; b < NB; ++b) a[b] = 0.f;
    for (int k = ks * 128; k < ks * 128 + 128; ++k) { const float w = p.w_ada[(size_t)k * (3 * D) + n];
#pragma unroll
        for (int b = 0; b < NB; ++b) a[b] += sc[b * D + k] * w; }
#pragma unroll
    for (int b = 0; b < NB; ++b) red[(ks * NB + b) * 64 + cl] = a[b];
    __syncthreads();
    { const int b = tid >> 6; float s = p.b_ada[n];
#pragma unroll
      for (int q = 0; q < 8; ++q) s += red[(q * NB + b) * 64 + cl];
      ((float*)(p.ws + WS_MOD))[(size_t)b * 3 * D + n] = s; }
    __syncthreads();
}
__device__ __forceinline__ void p0_transpose(ldsp lds, const float* W, int N, bf16_t* Wt, int kt, int nt, bool permute) {
    const int tid = threadIdx.x; LAS float* t = (LAS float*)lds;
    const int nn = tid & 63; int src = nn;
    if (permute) src = (nn & 1) ? (nn >> 1) + 32 : (nn >> 1);
#pragma unroll
    for (int i = 0; i < 8; ++i) { const int kk = i * 8 + (tid >> 6); t[kk * 65 + nn] = W[(size_t)(kt * 64 + kk) * N + nt * 64 + src]; }
    __syncthreads();
    { const int n2 = tid >> 3, k8 = (tid & 7) * 8; float v[8];
#pragma unroll
      for (int i = 0; i < 8; ++i) v[i] = t[(k8 + i) * 65 + n2];
      u32x4 w; w.x = pkbf(v[0], v[1]); w.y = pkbf(v[2], v[3]); w.z = pkbf(v[4], v[5]); w.w = pkbf(v[6], v[7]);
      *(u32x4*)(Wt + (size_t)(nt * 64 + n2) * D + kt * 64 + k8) = w; }
    __syncthreads();
}
__device__ __forceinline__ void sincos_d(double r, double& s, double& c) {
    const double r2 = r * r; double cs = 1.0, sn = 1.0;
    double tc = 1.0, ts = 1.0;
#pragma unroll
    for (int k = 1; k <= 13; ++k) { tc *= -r2 / (double)((2 * k - 1) * (2 * k)); ts *= -r2 / (double)((2 * k) * (2 * k + 1)); cs += tc; sn += ts; }
    c = cs; s = sn * r;
}
__device__ __forceinline__ void p0_tables(const Params& p) {
    const int gt = blockIdx.x * 512 + threadIdx.x, gs = gridDim.x * 512;
    float* lb = (float*)(p.ws + WS_LB); float* rope = (float*)(p.ws + WS_ROPE);
    for (int i = gt; i < D; i += gs) { const float l0 = p.lb_logits[i], l1 = p.lb_logits[D + i]; const float mx = fmaxf(l0, l1); const float e0 = __expf(l0 - mx), e1 = __expf(l1 - mx); lb[i] = e0 / (e0 + e1); }
    for (int i = gt; i < SEQ * 32; i += gs) { const int pos = i >> 5, j = i & 31;
        const float ex = (float)j * (1.0f / 31.0f);
        const float invf = 1.0f / (float)exp((double)ex * 9.210340371976184);
        const float ang = (float)pos * invf;
        const double a = (double)ang; const double n = rint(a * 0.15915494309189535); const double r = fma(-n, 6.283185307179586, a) - n * 2.4492935982947064e-16;
        double s, c; sincos_d(r, s, c);
        rope[2 * i] = (float)c; rope[2 * i + 1] = (float)s; }
}
__device__ __forceinline__ void p0_hnorm(const Params& p) {
    const int lane = threadIdx.x & 63, wave = threadIdx.x >> 6;
    const float* mod = (const float*)(p.ws + WS_MOD); bf16_t* H = (bf16_t*)(p.ws + WS_H);
    for (int row = blockIdx.x * 8 + wave; row < MTOT; row += gridDim.x * 8) {
        const float* xr = p.x + (size_t)row * D; const int b = row / SEQ;
        f32x4 v[4]; float ss = 0.f;
#pragma unroll
        for (int i = 0; i < 4; ++i) { v[i] = *(const f32x4*)(xr + i * 256 + lane * 4); ss += v[i][0] * v[i][0] + v[i][1] * v[i][1] + v[i][2] * v[i][2] + v[i][3] * v[i][3]; }
#pragma unroll
        for (int o = 1; o < 64; o <<= 1) ss += __shfl_xor(ss, o);
        const float rstd = rsqrtf(ss * (1.0f / D) + EPS);
#pragma unroll
        for (int i = 0; i < 4; ++i) { const int c0 = i * 256 + lane * 4;
            const f32x4 g = *(const f32x4*)(p.norm_g + c0), sh = *(const f32x4*)(mod + (size_t)b * 3 * D + c0), sc = *(const f32x4*)(mod + (size_t)b * 3 * D + D + c0);
            const f32x4 hv = v[i] * rstd * g * (sc + 1.0f) + sh;
            u32x2 w; w.x = pkbf(hv[0], hv[1]); w.y = pkbf(hv[2], hv[3]);
            *(u32x2*)(H + (size_t)row * D + c0) = w; }
    }
}
__device__ __forceinline__ void p4_final(const Params& p) {
    const int lane = threadIdx.x & 63, wave = threadIdx.x >> 6;
    for (int row = blockIdx.x * 8 + wave; row < MTOT; row += gridDim.x * 8) {
        float* xr = p.out + (size_t)row * D;
        f32x4 v[4]; float ss = 0.f;
#pragma unroll
        for (int i = 0; i < 4; ++i) { v[i] = *(const f32x4*)(xr + i * 256 + lane * 4); ss += v[i][0] * v[i][0] + v[i][1] * v[i][1] + v[i][2] * v[i][2] + v[i][3] * v[i][3]; }
#pragma unroll
        for (int o = 1; o < 64; o <<= 1) ss += __shfl_xor(ss, o);
        const float rstd = rsqrtf(ss * (1.0f / D) + EPS);
#pragma unroll
        for (int i = 0; i < 4; ++i) { const int c0 = i * 256 + lane * 4; const f32x4 g = *(const f32x4*)(p.final_g + c0); *(f32x4*)(xr + c0) = v[i] * rstd * g; }
    }
}

template <bool OUT>
__device__ __forceinline__ void prep_hg(const int tid, ldsp lds, const bf16_t* P, int h, float& gs0, float& gs1) {
    const int dp = tid & 63, sub = tid >> 6, d = 2 * dp;
    const unsigned voff = (unsigned)(((8 * sub) * DIN + h * 128 + d) * 2);
    unsigned qv[8], gv[8], vv[8];
#pragma unroll
    for (int i = 0; i < 8; ++i) { const char* rb = (const char*)P + (size_t)i * (DIN * 2);
        qv[i] = OUT ? *(const unsigned*)(rb + C_HQ * 2 + voff) : 0u; gv[i] = *(const unsigned*)(rb + C_HF * 2 + voff); vv[i] = *(const unsigned*)(rb + C_HI * 2 + voff); }
    float b0[8], b1[8]; float r0 = 0.f, r1 = 0.f;
#pragma unroll
    for (int i = 0; i < 8; ++i) { r0 += bflo(gv[i]); b0[i] = r0; r1 += bfhi(gv[i]); b1[i] = r1; }
    LAS float* SUB = (LAS float*)(lds + L_SUB);
    *(LAS f32x2v*)(SUB + sub * 128 + d) = (f32x2v){r0, r1};
    __syncthreads();
    float p0 = 0.f, p1 = 0.f, m0 = 0.f, m1 = 0.f, t0 = 0.f, t1 = 0.f;
#pragma unroll
    for (int s = 0; s < 8; ++s) { const f32x2v x = *(const LAS f32x2v*)(SUB + s * 128 + d);
        if (s < sub) { p0 += x.x; p1 += x.y; } if (s < 4) { m0 += x.x; m1 += x.y; } t0 += x.x; t1 += x.y; }
    if (sub == 0) { LAS float* EM = (LAS float*)(lds + L_EM); EM[d] = __expf(m0); EM[d + 1] = __expf(m1); EM[128 + d] = __expf(t0 - m0); EM[128 + d + 1] = __expf(t1 - m1); }
    gs0 += t0; gs1 += t1;
    unsigned kt0[4], kt1[4], vt0[4], vt1[4]; float kp0 = 0.f, kp1 = 0.f;
#pragma unroll
    for (int i = 0; i < 8; ++i) { const int t = 8 * sub + i;
        const float x0 = fminf(fmaxf(p0 + b0[i] - m0, -80.f), 80.f), x1 = fminf(fmaxf(p1 + b1[i] - m1, -80.f), 80.f);
        const float k0 = (1.0f - __expf(bflo(gv[i]))) * __expf(-x0), k1 = (1.0f - __expf(bfhi(gv[i]))) * __expf(-x1);
        if (OUT) { *(LAS unsigned*)(lds + L_QT + t * RS_D + d * 2) = pkbf(bflo(qv[i]) * __expf(x0), bfhi(qv[i]) * __expf(x1));
                   *(LAS unsigned*)(lds + L_KT + t * RS_D + d * 2) = pkbf(k0, k1); }
        if (i & 1) { kt0[i >> 1] = pkbf(kp0, k0); kt1[i >> 1] = pkbf(kp1, k1);
                     vt0[i >> 1] = (vv[i - 1] & 0xffffu) | (vv[i] << 16); vt1[i >> 1] = (vv[i - 1] >> 16) | (vv[i] & 0xffff0000u); }
        else { kp0 = k0; kp1 = k1; } }
    *(LAS u32x4*)(lds + L_KTT + d * RS_S + sub * 16) = (u32x4){kt0[0], kt0[1], kt0[2], kt0[3]};
    *(LAS u32x4*)(lds + L_KTT + (d + 1) * RS_S + sub * 16) = (u32x4){kt1[0], kt1[1], kt1[2], kt1[3]};
    *(LAS u32x4*)(lds + L_VT + d * RS_S + sub * 16) = (u32x4){vt0[0], vt0[1], vt0[2], vt0[3]};
    *(LAS u32x4*)(lds + L_VT + (d + 1) * RS_S + sub * 16) = (u32x4){vt1[0], vt1[1], vt1[2], vt1[3]};
}
template <bool OUT>
__device__ __forceinline__ void prep_rt(const int tid, ldsp lds, const bf16_t* P, int h, float lg) {
    { const int dp = tid & 31, sub = tid >> 5, d = 2 * dp;
      const unsigned voff = (unsigned)(((4 * sub) * DIN + h * 64 + d) * 2);
      unsigned qv[4], kv[4];
#pragma unroll
      for (int i = 0; i < 4; ++i) { const char* rb = (const char*)P + (size_t)i * (DIN * 2);
          qv[i] = OUT ? *(const unsigned*)(rb + C_RQ * 2 + voff) : 0u; kv[i] = *(const unsigned*)(rb + C_RK * 2 + voff); }
      unsigned kt0[2], kt1[2]; float kp0 = 0.f, kp1 = 0.f;
#pragma unroll
      for (int i = 0; i < 4; ++i) { const int t = 4 * sub + i; const float ek = __expf((float)(31 - t) * lg);
          const float k0 = bflo(kv[i]) * ek, k1 = bfhi(kv[i]) * ek;
          if (OUT) { const float eq = __expf((float)(t - 31) * lg);
                     *(LAS unsigned*)(lds + L_QT + t * RS_D + d * 2) = pkbf(bflo(qv[i]) * eq, bfhi(qv[i]) * eq);
                     *(LAS unsigned*)(lds + L_KT + t * RS_D + d * 2) = pkbf(k0, k1); }
          if (i & 1) { kt0[i >> 1] = pkbf(kp0, k0); kt1[i >> 1] = pkbf(kp1, k1); } else { kp0 = k0; kp1 = k1; } }
      *(LAS u32x2*)(lds + L_KTT + d * RS_S + sub * 8) = (u32x2){kt0[0], kt0[1]};
      *(LAS u32x2*)(lds + L_KTT + (d + 1) * RS_S + sub * 8) = (u32x2){kt1[0], kt1[1]}; }
    { const int ep = tid & 63, sub = tid >> 6, e = 2 * ep;
      const unsigned voff = (unsigned)(((8 * sub) * DIN + h * 128 + e) * 2);
      unsigned vv[8], vt0[4], vt1[4];
#pragma unroll
      for (int i = 0; i < 8; ++i) vv[i] = *(const unsigned*)((const char*)P + (size_t)i * (DIN * 2) + C_RV * 2 + voff);
#pragma unroll
      for (int i = 0; i < 4; ++i) { vt0[i] = (vv[2 * i] & 0xffffu) | (vv[2 * i + 1] << 16); vt1[i] = (vv[2 * i] >> 16) | (vv[2 * i + 1] & 0xffff0000u); }
      *(LAS u32x4*)(lds + L_VT + e * RS_S + sub * 16) = (u32x4){vt0[0], vt0[1], vt0[2], vt0[3]};
      *(LAS u32x4*)(lds + L_VT + (e + 1) * RS_S + sub * 16) = (u32x4){vt1[0], vt1[1], vt1[2], vt1[3]}; }
    if (tid < 64) { const float e32 = __expf(32.0f * lg); LAS float* EM = (LAS float*)(lds + L_EM); EM[tid] = e32; EM[128 + tid] = e32; }
}
template <int DK, bool OUT>
__device__ __forceinline__ void mix_core(const int tid, ldsp lds, f32x4 (&S)[DK == 128 ? 8 : 4]) {
    constexpr int NE = DK == 128 ? 8 : 4;
    const int w = __builtin_amdgcn_readfirstlane(tid >> 6), lane = tid & 63, l15 = lane & 15, quad = lane >> 4;
    const int db = DK == 128 ? w : (w & 3), eb0 = DK == 128 ? 0 : (w >> 2) * 4;
    __syncthreads();
    { const f32x4 em4 = *(const LAS f32x4*)(lds + L_EM + (db * 16 + quad * 4) * 4);
#pragma unroll
      for (int i = 0; i < NE; ++i) S[i] *= em4; }
    if (OUT) {
#pragma unroll
        for (int i = 0; i < NE; ++i) *(LAS u32x2*)(lds + L_SM + ((eb0 + i) * 16 + l15) * RS_D + (db * 16 + quad * 4) * 2) = (u32x2){pkbf(S[i][0], S[i][1]), pkbf(S[i][2], S[i][3])};
        const int tb = w & 3;
#pragma unroll
        for (int si = 0; si < 2; ++si) { const int sb = (w >> 2) * 2 + si; f32x4 a = (f32x4){0.f, 0.f, 0.f, 0.f};
            if (sb <= tb) {
#pragma unroll
                for (int ks = 0; ks < DK / 32; ++ks) { const bf16x8 af = *(const LAS bf16x8*)(lds + L_QT + (tb * 16 + l15) * RS_D + (ks * 32 + quad * 8) * 2);
                    const bf16x8 bf = *(const LAS bf16x8*)(lds + L_KT + (sb * 16 + l15) * RS_D + (ks * 32 + quad * 8) * 2);
                    a = __builtin_amdgcn_mfma_f32_16x16x32_bf16(af, bf, a, 0, 0, 0); }
            }
#pragma unroll
            for (int j = 0; j < 4; ++j) { const int t = tb * 16 + quad * 4 + j, s = sb * 16 + l15; const float v = (s <= t) ? a[j] : 0.f;
                *(LAS unsigned short*)(lds + L_AM + t * RS_S + s * 2) = (unsigned short)(pkbf(v, 0.f) & 0xffffu); }
        }
        __syncthreads();
        f32x4 o[4];
#pragma unroll
        for (int i = 0; i < 4; ++i) o[i] = (f32x4){0.f, 0.f, 0.f, 0.f};
        const int oe0 = (w >> 2) * 4;
#pragma unroll
        for (int ks = 0; ks < DK / 32; ++ks) { const bf16x8 af = *(const LAS bf16x8*)(lds + L_QT + (tb * 16 + l15) * RS_D + (ks * 32 + quad * 8) * 2);
#pragma unroll
            for (int i = 0; i < 4; ++i) { const bf16x8 bf = *(const LAS bf16x8*)(lds + L_SM + ((oe0 + i) * 16 + l15) * RS_D + (ks * 32 + quad * 8) * 2);
                o[i] = __builtin_amdgcn_mfma_f32_16x16x32_bf16(af, bf, o[i], 0, 0, 0); }
            __builtin_amdgcn_sched_barrier(0); }
#pragma unroll
        for (int ks = 0; ks < 2; ++ks) { const bf16x8 af = *(const LAS bf16x8*)(lds + L_AM + (tb * 16 + l15) * RS_S + (ks * 32 + quad * 8) * 2);
#pragma unroll
            for (int i = 0; i < 4; ++i) { const bf16x8 bf = *(const LAS bf16x8*)(lds + L_VT + ((oe0 + i) * 16 + l15) * RS_S + (ks * 32 + quad * 8) * 2);
                o[i] = __builtin_amdgcn_mfma_f32_16x16x32_bf16(af, bf, o[i], 0, 0, 0); }
            __builtin_amdgcn_sched_barrier(0); }
#pragma unroll
        for (int i = 0; i < 4; ++i)
#pragma unroll
            for (int j = 0; j < 4; ++j) *(LAS float*)(lds + L_OF + (tb * 16 + quad * 4 + j) * RS_O + ((oe0 + i) * 16 + l15) * 4) = o[i][j];
    }
#pragma unroll
    for (int ks = 0; ks < 2; ++ks) { const bf16x8 af = *(const LAS bf16x8*)(lds + L_KTT + (db * 16 + l15) * RS_S + (ks * 32 + quad * 8) * 2);
#pragma unroll
        for (int i = 0; i < NE; ++i) { const bf16x8 bf = *(const LAS bf16x8*)(lds + L_VT + ((eb0 + i) * 16 + l15) * RS_S + (ks * 32 + quad * 8) * 2);
            S[i] = __builtin_amdgcn_mfma_f32_16x16x32_bf16(af, bf, S[i], 0, 0, 0); }
        __builtin_amdgcn_sched_barrier(0); }
    { const f32x4 ed4 = *(const LAS f32x4*)(lds + L_EM + (128 + db * 16 + quad * 4) * 4);
#pragma unroll
      for (int i = 0; i < NE; ++i) S[i] *= ed4; }
    __syncthreads();
}
__device__ __forceinline__ void epi_mix(const int tid, ldsp lds, const bf16_t* Prow, int zcol, int gcol, const float* gn, float (&am)[16], bool first) {
    const int t = tid >> 3, c = tid & 7;
    f32x4 o[4]; float ss = 0.f;
#pragma unroll
    for (int i = 0; i < 4; ++i) { o[i] = *(const LAS f32x4*)(lds + L_OF + t * RS_O + c * 64 + i * 16); ss += o[i][0] * o[i][0] + o[i][1] * o[i][1] + o[i][2] * o[i][2] + o[i][3] * o[i][3]; }
    ss += __shfl_xor(ss, 1); ss += __shfl_xor(ss, 2); ss += __shfl_xor(ss, 4);
    const float rstd = rsqrtf(ss * (1.0f / 128.0f) + EPS);
    const unsigned voff = (unsigned)((t * DIN + 16 * c) * 2);
    const u32x4 z0 = *(const u32x4*)((const char*)Prow + zcol * 2 + voff), z1 = *(const u32x4*)((const char*)Prow + zcol * 2 + 16 + voff);
    const u32x4 g0 = *(const u32x4*)((const char*)Prow + gcol * 2 + voff), g1 = *(const u32x4*)((const char*)Prow + gcol * 2 + 16 + voff);
#pragma unroll
    for (int i = 0; i < 4; ++i) { const f32x4 gg = *(const f32x4*)(gn + 16 * c + 4 * i);
        const unsigned zw0 = i < 2 ? z0[2 * i] : z1[2 * i - 4], zw1 = i < 2 ? z0[2 * i + 1] : z1[2 * i - 3];
        const unsigned gw0 = i < 2 ? g0[2 * i] : g1[2 * i - 4], gw1 = i < 2 ? g0[2 * i + 1] : g1[2 * i - 3];
        const float v0 = o[i][0] * rstd * gg[0] * bflo(zw0) * bflo(gw0), v1 = o[i][1] * rstd * gg[1] * bfhi(zw0) * bfhi(gw0);
        const float v2 = o[i][2] * rstd * gg[2] * bflo(zw1) * bflo(gw1), v3 = o[i][3] * rstd * gg[3] * bfhi(zw1) * bfhi(gw1);
        if (first) { am[4 * i] = v0; am[4 * i + 1] = v1; am[4 * i + 2] = v2; am[4 * i + 3] = v3; }
        else { am[4 * i] += v0; am[4 * i + 1] += v1; am[4 * i + 2] += v2; am[4 * i + 3] += v3; } }
}

__device__ __forceinline__ void p2a(ldsp lds, const Params& p) {
    const bf16_t* proj = (const bf16_t*)(p.ws + WS_PROJ);
    int tid_ = threadIdx.x; asm volatile("" : "+v"(tid_)); const int tid = tid_;
    for (int u = blockIdx.x; u < 256; u += gridDim.x) {
        const int seg = u & 7, h = (u >> 3) & 7, bl = u >> 6;
        if (seg == NSEG - 1) continue;
        const float lg = log1pf(-exp2f(-5.0f - (float)h));
        f32x4 SA[8], SB[4];
#pragma unroll
        for (int i = 0; i < 8; ++i) SA[i] = (f32x4){0.f, 0.f, 0.f, 0.f};
#pragma unroll
        for (int i = 0; i < 4; ++i) SB[i] = (f32x4){0.f, 0.f, 0.f, 0.f};
        float gs0 = 0.f, gs1 = 0.f;
        const size_t row0 = (size_t)bl * SEQ + (size_t)seg * SEGLEN;
        for (int c = 0; c < NCH; ++c) { const bf16_t* P = proj + (row0 + (size_t)c * 64) * DIN;
            prep_hg<false>(tid, lds, P, h, gs0, gs1); mix_core<128, false>(tid, lds, SA);
            prep_rt<false>(tid, lds, P, h, lg);       mix_core<64, false>(tid, lds, SB); }
        float* sla = (float*)(p.ws + WS_SLA) + (size_t)u * 16384; float* slb = (float*)(p.ws + WS_SLB) + (size_t)u * 8192; float* da = (float*)(p.ws + WS_DA) + (size_t)u * 128;
#pragma unroll
        for (int i = 0; i < 8; ++i) *(f32x4*)((char*)sla + (unsigned)(tid * 128 + i * 16)) = SA[i];
#pragma unroll
        for (int i = 0; i < 4; ++i) *(f32x4*)((char*)slb + (unsigned)(tid * 64 + i * 16)) = SB[i];
        if (tid < 64) { da[2 * tid] = __expf(gs0); da[2 * tid + 1] = __expf(gs1); }
    }
}
__device__ __forceinline__ void p2b(ldsp lds, const Params& p, int half) {
    const bf16_t* proj = (const bf16_t*)(p.ws + WS_PROJ);
    bf16_t* Mo = (bf16_t*)(p.ws + WS_H) + (size_t)half * MH * D;
    int tid_ = threadIdx.x; asm volatile("" : "+v"(tid_)); const int tid = tid_, w = __builtin_amdgcn_readfirstlane(tid >> 6), lane = tid & 63, quad = lane >> 4;
    for (int u = blockIdx.x; u < 256; u += gridDim.x) {
        const int seg = u & 7, h = (u >> 3) & 7, bl = u >> 6;
        const float lg = log1pf(-exp2f(-5.0f - (float)h));
        const float dB = __expf((float)SEGLEN * lg);
        f32x4 SA[8], SB[4];
#pragma unroll
        for (int i = 0; i < 8; ++i) SA[i] = (f32x4){0.f, 0.f, 0.f, 0.f};
#pragma unroll
        for (int i = 0; i < 4; ++i) SB[i] = (f32x4){0.f, 0.f, 0.f, 0.f};
        for (int s = 0; s < seg; ++s) { const int uu = u - seg + s;
            const float* sla = (const float*)(p.ws + WS_SLA) + (size_t)uu * 16384; const float* slb = (const float*)(p.ws + WS_SLB) + (size_t)uu * 8192;
            const f32x4 d4 = *(const f32x4*)((const float*)(p.ws + WS_DA) + (size_t)uu * 128 + w * 16 + quad * 4);
#pragma unroll
            for (int i = 0; i < 8; ++i) SA[i] = SA[i] * d4 + *(const f32x4*)((const char*)sla + (unsigned)(tid * 128 + i * 16));
#pragma unroll
            for (int i = 0; i < 4; ++i) SB[i] = SB[i] * dB + *(const f32x4*)((const char*)slb + (unsigned)(tid * 64 + i * 16)); }
        float gs0 = 0.f, gs1 = 0.f;
        const size_t row0 = (size_t)bl * SEQ + (size_t)seg * SEGLEN;
        const int t = tid >> 3, c8 = tid & 7;
        for (int c = 0; c < NCH; ++c) { const bf16_t* P = proj + (row0 + (size_t)c * 64) * DIN;
            float am[16];
            prep_hg<true>(tid, lds, P, h, gs0, gs1); mix_core<128, true>(tid, lds, SA);
            epi_mix(tid, lds, P + h * 128, C_HZ, C_GA, p.hg_norm_g + h * 128, am, true);
            prep_rt<true>(tid, lds, P, h, lg);       mix_core<64, true>(tid, lds, SB);
            epi_mix(tid, lds, P + h * 128, C_RZ, C_GB, p.ret_norm_g + h * 128, am, false);
            bf16_t* mo = Mo + (row0 + (size_t)c * 64 + t) * D + h * 128 + 16 * c8;
            *(u32x4*)mo = (u32x4){pkbf(am[0], am[1]), pkbf(am[2], am[3]), pkbf(am[4], am[5]), pkbf(am[6], am[7])};
            *(u32x4*)(mo + 8) = (u32x4){pkbf(am[8], am[9]), pkbf(am[10], am[11]), pkbf(am[12], am[13]), pkbf(am[14], am[15])};
        }
    }
}

__global__ void __launch_bounds__(512, 2) fwd_megakernel(Params p) {
    extern __shared__ __attribute__((aligned(16))) unsigned char lds_raw[];
    ldsp lds = (ldsp)lds_raw;
    cg::grid_group grid = cg::this_grid();
    const int G = gridDim.x;
    for (int j = blockIdx.x; j < 48; j += G) p0_mod(lds, p, j);
    p0_tables(p);
    for (int tI = blockIdx.x; tI < 144 * 16 + 16 * 16; tI += G) {
        if (tI < 144 * 16) { const int nt = tI / 16, kt = tI % 16; p0_transpose(lds, p.w_in, DIN, (bf16_t*)(p.ws + WS_WIN), kt, nt, nt >= C_RQ / 64 && nt < C_RV / 64); }
        else { const int q = tI - 144 * 16; p0_transpose(lds, p.w_out, D, (bf16_t*)(p.ws + WS_WOUT), q % 16, q / 16, false); }
    }
    grid.sync();
    p0_hnorm(p);
    grid.sync();
    for (int half = 0; half < 2; ++half) {
        { pg8::Gemm g{(const bf16_t*)(p.ws + WS_H) + (size_t)half * MH * D, (const bf16_t*)(p.ws + WS_WIN), MH, DIN, D};
          pg8::StaticOrder S; S.init(MH, DIN, G, (int)blockIdx.x);
          EpiProj E{(bf16_t*)(p.ws + WS_PROJ), (const float*)(p.ws + WS_LB), (const float*)(p.ws + WS_ROPE)};
          pg8::gemm_phase<EpiProj, pg8::StaticOrder, false>(lds, g, S, E, nullptr); }
        grid.sync();
        p2a(lds, p);
        grid.sync();
        p2b(lds, p, half);
        grid.sync();
    }
    { pg8::Gemm g{(const bf16_t*)(p.ws + WS_H), (const bf16_t*)(p.ws + WS_WOUT), MTOT, D, D};
      pg8::StaticOrder S; S.init(MTOT, D, G, (int)blockIdx.x);
      EpiRes E{p.x, p.out, (const float*)(p.ws + WS_MOD)};
      pg8::gemm_phase<EpiRes, pg8::StaticOrder, false>(lds, g, S, E, nullptr); }
    grid.sync();
    p4_final(p);
}

extern "C" void kernel_launch(void* const* d_in, const int* in_sizes, int n_in, void* d_out, int out_size, void* d_ws, size_t ws_size, hipStream_t stream) {
    static int grid = 0;
    if (grid == 0) {
        if (n_in != 11 || out_size != MTOT * D || ws_size < WS_END) { fprintf(stderr, "kernel_launch: unexpected shapes (n_in %d out %d ws %zu)\n", n_in, out_size, ws_size); grid = -1; return; }
        int dev = 0, cus = 0, per_cu = 0;
        hipGetDevice(&dev); hipDeviceGetAttribute(&cus, hipDeviceAttributeMultiprocessorCount, dev);
        if (hipFuncSetAttribute((const void*)fwd_megakernel, hipFuncAttributeMaxDynamicSharedMemorySize, LDS_BYTES) != hipSuccess) { fprintf(stderr, "kernel_launch: hipFuncSetAttribute failed\n"); grid = -1; return; }
        if (hipOccupancyMaxActiveBlocksPerMultiprocessor(&per_cu, (const void*)fwd_megakernel, 512, LDS_BYTES) != hipSuccess || per_cu < 1) { fprintf(stderr, "kernel_launch: occupancy query failed (%d)\n", per_cu); per_cu = 1; }
        (void)hipGetLastError();
        grid = cus;
        fprintf(stderr, "kernel_launch: cus %d per_cu %d grid %d\n", cus, per_cu, grid);
    }
    if (grid < 0) return;
    Params p{};
    p.x = (const float*)d_in[0]; p.c = (const float*)d_in[1]; p.norm_g = (const float*)d_in[2]; p.w_ada = (const float*)d_in[3]; p.b_ada = (const float*)d_in[4];
    p.w_in = (const float*)d_in[5]; p.lb_logits = (const float*)d_in[6]; p.hg_norm_g = (const float*)d_in[7]; p.ret_norm_g = (const float*)d_in[8]; p.w_out = (const float*)d_in[9];
    p.final_g = (const float*)d_in[10]; p.out = (float*)d_out; p.ws = (unsigned char*)d_ws;
    void* args[] = {&p};
    hipError_t e = hipLaunchCooperativeKernel((const void*)fwd_megakernel, dim3(grid), dim3(512), args, LDS_BYTES, stream);
    if (e != hipSuccess) fprintf(stderr, "kernel_launch: cooperative launch failed: %s (grid %d)\n", hipGetErrorString(e), grid);
}
```

```cpp
#include <hip/hip_runtime.h>
#include <hip/hip_cooperative_groups.h>
#include <cstdio>
namespace cg = cooperative_groups;
namespace pg8 {
#define PG8_LAS __attribute__((address_space(3)))
typedef unsigned short bf16_t;
typedef short bf16x8 __attribute__((ext_vector_type(8)));
typedef float f32x4 __attribute__((ext_vector_type(4)));
typedef unsigned u32x4 __attribute__((ext_vector_type(4)));
constexpr int BM = 256, BK = 64, HALF = 128, HTB = HALF * BK * 2  , STAGE_BYTES = 8 * HTB, NXCD = 8, WGM = 8;

__host__ __device__ __forceinline__ int lds_byte(int r, int c) { const int st = (r >> 4) * 2 + (c >> 5), rr = r & 15, cc = c & 31, ob = rr * 64 + cc * 2; return st * 1024 + (ob ^ (((ob >> 9) & 1) << 5)); }
__host__ __device__ __forceinline__ void stage_rc(int b, int& R, int& C) { const int st = b / 1024, sb = b % 1024, swz = sb ^ (((sb >> 9) & 1) << 5); R = (st >> 1) * 16 + swz / 64; C = (st & 1) * 32 + (swz % 64) / 2; }
__host__ __device__ __forceinline__ int perm32(int rho) { const int n = rho >> 4, i = rho & 15; return 8 * (i >> 2) + 4 * n + (i & 3); }

struct Unit { int pm, pn; };
struct Gemm { const bf16_t* A; const bf16_t* Bt; int M, N, K; };
struct StaticOrder {
    int nM, nN, nwg, G, c;
    __host__ __device__ void init(int M, int N, int G_, int c_) { nM = M / BM; nN = N / BM; nwg = nM * nN; G = G_; c = c_; }
    __host__ __device__ bool next(int i, Unit& u) const {
        const long L = (long)i * G + c; if (L >= nwg) return false;
        int wgid = (int)L; { const int q = nwg / NXCD, r = nwg % NXCD, xcd = wgid % NXCD, off = wgid / NXCD; wgid = (xcd < r ? xcd * (q + 1) : r * (q + 1) + (xcd - r) * q) + off; }
        const int nig = WGM * nN, gid = wgid / nig, fm = gid * WGM, gsz = (nM - fm) < WGM ? (nM - fm) : WGM;
        u.pm = fm + ((wgid % nig) % gsz); u.pn = (wgid % nig) / gsz; return true;
    }
    __device__ __forceinline__ void a_ready(const Unit&) const {}
    __device__ __forceinline__ void done(const Unit&) const {}
};
__device__ __forceinline__ unsigned cvt_pk_bf16(float lo, float hi) { unsigned r; asm volatile("v_cvt_pk_bf16_f32 %0, %1, %2" : "=v"(r) : "v"(lo), "v"(hi)); return r; }
typedef float f32x2 __attribute__((ext_vector_type(2)));
template <class Epi, class Sched, bool STAMP = false>
__device__ __forceinline__ void gemm_phase(PG8_LAS unsigned char* lds, const Gemm g, const Sched& S, const Epi& E, unsigned long long* stamps) {
    int tid_ = threadIdx.x; asm volatile("" : "+v"(tid_)); const int tid = tid_, wid = __builtin_amdgcn_readfirstlane(tid >> 6), lane = tid & 63, wr = wid >> 2, wc = wid & 3, fr = lane & 15, fq = lane >> 4;
    const int K = g.K, nt = K / BK;
    int ts_lo = 0, ts_hi = 0, nts = 0; const unsigned long long rt_entry = STAMP ? (unsigned long long)wall_clock64() : 0ull;
#define PG8_STAMP() do { if (STAMP && wid == 0 && nts < 64) { const unsigned long long _c = (unsigned long long)clock64(); \
        ts_lo = (lane == nts) ? (int)(unsigned)_c : ts_lo; ts_hi = (lane == nts) ? (int)(unsigned)(_c >> 32) : ts_hi; ++nts; } } while (0)
    PG8_STAMP();
    unsigned voffA[2], voffB[2];
#pragma unroll
    for (int i = 0; i < 2; ++i) { int R, C; stage_rc(tid * 16 + i * 8192, R, C); const int Rb = Epi::PERM ? ((R & ~31) + perm32(R & 31)) : R;
        voffA[i] = (unsigned)(R * K + C) * 2u; voffB[i] = (unsigned)(Rb * K + C) * 2u; }
    const size_t kstep = (size_t)(BK * 2);
    const size_t hstep = (size_t)HALF * K * 2;
    const size_t tstep = 2 * hstep;
    const unsigned ldsw = (unsigned)wid * 1024u;
    const int aoff = lds_byte(wr * 64 + fr, fq * 8), boff = lds_byte(wc * 32 + fr, fq * 8);
#define PG8_SA(b, h) (((b) * 2 + (h)) * HTB)
#define PG8_SB(b, h) ((4 + (b) * 2 + (h)) * HTB)
#define PG8_STAGE(bufoff, gbase, voff) do { _Pragma("unroll") for (int _i = 0; _i < 2; ++_i) \
        __builtin_amdgcn_global_load_lds((const unsigned*)((const char*)(gbase) + (voff)[_i]), (PG8_LAS unsigned*)(lds + (bufoff) + ldsw + _i * 8192), 16, 0, 0); } while (0)
#define PG8_LDA(dst, b, h) do { _Pragma("unroll") for (int m = 0; m < 4; ++m) _Pragma("unroll") for (int k = 0; k < 2; ++k) dst[m][k] = *(const PG8_LAS bf16x8*)(lds + PG8_SA(b, h) + aoff + m * 2048 + k * 1024); } while (0)
#define PG8_LDB(dst, b, h) do { _Pragma("unroll") for (int n = 0; n < 2; ++n) _Pragma("unroll") for (int k = 0; k < 2; ++k) dst[n][k] = *(const PG8_LAS bf16x8*)(lds + PG8_SB(b, h) + boff + n * 2048 + k * 1024); } while (0)
#define PG8_MMA(ai, bj, At, Bt) do { __builtin_amdgcn_s_setprio(1); _Pragma("unroll") for (int m = 0; m < 4; ++m) _Pragma("unroll") for (int n = 0; n < 2; ++n) _Pragma("unroll") for (int k = 0; k < 2; ++k) \
        acc[ai][bj][m][n] = __builtin_amdgcn_mfma_f32_16x16x32_bf16(Bt[n][k], At[m][k], acc[ai][bj][m][n], 0, 0, 0); __builtin_amdgcn_s_setprio(0); } while (0)
#define PG8_WAIT_V(n) asm volatile("s_waitcnt vmcnt(" #n ")" ::: "memory")
#define PG8_WAIT_L(n) asm volatile("s_waitcnt lgkmcnt(" #n ")" ::: "memory")
#define PG8_BAR __builtin_amdgcn_s_barrier()
#define PG8_SCHED __builtin_amdgcn_sched_barrier(0)
    Unit cur, nxt; int ui = 0;
    if (!S.next(0, cur)) return;
    f32x4 acc[2][2][4][2];
#pragma unroll
    for (int a = 0; a < 2; ++a)
#pragma unroll
        for (int b = 0; b < 2; ++b)
#pragma unroll
            for (int m = 0; m < 4; ++m)
#pragma unroll
                for (int n = 0; n < 2; ++n) acc[a][b][m][n] = (f32x4){0.f, 0.f, 0.f, 0.f};
    bf16x8 At[4][2], B0[2][2], B1[2][2];
    const char* cA = (const char*)g.A + (size_t)cur.pm * tstep; const char* cB = (const char*)g.Bt + (size_t)cur.pn * tstep;
    S.a_ready(cur);
    PG8_STAGE(PG8_SB(0, 0), cB, voffB); PG8_STAGE(PG8_SA(0, 0), cA, voffA); PG8_STAGE(PG8_SB(0, 1), cB + hstep, voffB); PG8_STAGE(PG8_SA(0, 1), cA + hstep, voffA);
    if (wr == 1) PG8_BAR;
    PG8_WAIT_V(4); PG8_BAR;
    PG8_STAGE(PG8_SB(1, 0), cB + kstep, voffB); PG8_STAGE(PG8_SA(1, 0), cA + kstep, voffA); PG8_STAGE(PG8_SB(1, 1), cB + hstep + kstep, voffB);
    PG8_WAIT_V(6); PG8_BAR;
    PG8_STAMP();
    for (;;) {
        const bool has_next = S.next(ui + 1, nxt);
        const char* nA = has_next ? (const char*)g.A + (size_t)nxt.pm * tstep : cA; const char* nB = has_next ? (const char*)g.Bt + (size_t)nxt.pn * tstep : cB;
        for (int t = 0; t < nt; t += 2) {
            const bool last = (t == nt - 2);
            const char* a1 = cA + (size_t)(t + 1) * kstep;
            const char* a2 = last ? nA : cA + (size_t)(t + 2) * kstep; const char* b2 = last ? nB : cB + (size_t)(t + 2) * kstep;
            const char* a3 = a2 + kstep; const char* b3 = b2 + kstep;
            if (last && has_next) S.a_ready(nxt);
            PG8_LDB(B0, 0, 0); PG8_SCHED; PG8_LDA(At, 0, 0); PG8_STAGE(PG8_SA(1, 1), a1 + hstep, voffA);
            PG8_WAIT_L(8); PG8_BAR; PG8_WAIT_L(0); PG8_MMA(0, 0, At, B0); PG8_BAR; PG8_SCHED;
            PG8_LDB(B1, 0, 1); PG8_STAGE(PG8_SB(0, 0), b2, voffB);
            PG8_BAR; PG8_WAIT_L(0); PG8_MMA(0, 1, At, B1); PG8_BAR;
            PG8_LDA(At, 0, 1); PG8_STAGE(PG8_SA(0, 0), a2, voffA);
            PG8_BAR; PG8_WAIT_L(0); PG8_MMA(1, 0, At, B0); PG8_BAR; PG8_SCHED;
            PG8_STAGE(PG8_SB(0, 1), b2 + hstep, voffB);
            PG8_WAIT_V(6); PG8_BAR; PG8_MMA(1, 1, At, B1); PG8_BAR;
            PG8_LDB(B0, 1, 0); PG8_SCHED; PG8_LDA(At, 1, 0); PG8_STAGE(PG8_SA(0, 1), a2 + hstep, voffA);
            PG8_WAIT_L(8); PG8_BAR; PG8_WAIT_L(0); PG8_MMA(0, 0, At, B0); PG8_BAR; PG8_SCHED;
            PG8_LDB(B1, 1, 1); PG8_STAGE(PG8_SB(1, 0), b3, voffB);
            PG8_BAR; PG8_WAIT_L(0); PG8_MMA(0, 1, At, B1); PG8_BAR;
            PG8_LDA(At, 1, 1); PG8_STAGE(PG8_SA(1, 0), a3, voffA);
            PG8_BAR; PG8_WAIT_L(0); PG8_MMA(1, 0, At, B0); PG8_BAR; PG8_SCHED;
            PG8_STAGE(PG8_SB(1, 1), b3 + hstep, voffB);
            PG8_WAIT_V(6); PG8_BAR; PG8_MMA(1, 1, At, B1); PG8_BAR;
        }
        PG8_STAMP();
        if constexpr (!Epi::AFTER_DRAIN) { E(acc, cur, wr, wc, fr, fq); S.done(cur); }
        PG8_STAMP();
        if (!has_next) break;
#pragma unroll
        for (int a = 0; a < 2; ++a)
#pragma unroll
            for (int b = 0; b < 2; ++b)
#pragma unroll
                for (int m = 0; m < 4; ++m)
#pragma unroll
                    for (int n = 0; n < 2; ++n) acc[a][b][m][n] = (f32x4){0.f, 0.f, 0.f, 0.f};
        cur = nxt; cA = nA; cB = nB; ++ui;
    }
    PG8_WAIT_V(0);
    if (wr == 0) PG8_BAR;
    PG8_BAR;
    if constexpr (Epi::AFTER_DRAIN) { E.fused(acc, cur, wr, wc, fr, fq, lds, wid, lane); S.done(cur); }
    PG8_STAMP();
    if (STAMP && wid == 0) { stamps[lane] = lane < nts ? (((unsigned long long)(unsigned)ts_hi << 32) | (unsigned)ts_lo) : 0ull;
        if (lane == 62) stamps[62] = rt_entry; if (lane == 63) stamps[63] = (unsigned long long)wall_clock64(); }
#undef PG8_STAMP
#undef PG8_SA
#undef PG8_SB
#undef PG8_STAGE
#undef PG8_LDA
#undef PG8_LDB
#undef PG8_MMA
#undef PG8_WAIT_V
#undef PG8_WAIT_L
#undef PG8_BAR
#undef PG8_SCHED
}
}

using pg8::bf16_t; using pg8::bf16x8; using pg8::f32x4; using pg8::u32x4; using pg8::Unit;
#define LAS __attribute__((address_space(3)))
typedef LAS unsigned char* ldsp;
typedef unsigned u32x2 __attribute__((ext_vector_type(2)));
typedef float f32x2v __attribute__((ext_vector_type(2)));

constexpr int D = 1024, NB = 8, SEQ = 4096, MTOT = NB * SEQ, DIN = 9216;
constexpr int MH = MTOT / 2;
constexpr float EPS = 1e-6f;
constexpr int C_HQ = 0, C_HF = 1024, C_HI = 2048, C_HZ = 3072, C_RQ = 4096, C_RK = 4608, C_RV = 5120, C_RZ = 6144, C_GA = 7168, C_GB = 8192;
constexpr int NSEG = 8, SEGLEN = 512, NCH = SEGLEN / 64;
constexpr size_t MiB = 1u << 20;
constexpr size_t WS_MOD = 0, WS_LB = 131072, WS_ROPE = 262144, WS_WIN = 2 * MiB, WS_WOUT = 20 * MiB, WS_SLA = 22 * MiB, WS_SLB = 38 * MiB, WS_DA = 46 * MiB,
                 WS_H = 48 * MiB, WS_PROJ = 112 * MiB, WS_END = 400 * MiB;
constexpr int L_QT = 0, L_KT = 17408, L_KTT = 34816, L_VT = 53248, L_SM = 71680, L_AM = 106496, L_OF = 115712, L_SUB = 149504, L_EM = 153600, LDS_BYTES = 154624;
constexpr int RS_D = 272, RS_S = 144, RS_O = 528;

__device__ __forceinline__ unsigned pkbf(float lo, float hi) { return pg8::cvt_pk_bf16(lo, hi); }
__device__ __forceinline__ float bflo(unsigned w) { return __uint_as_float(w << 16); }
__device__ __forceinline__ float bfhi(unsigned w) { return __uint_as_float(w & 0xffff0000u); }
__device__ __forceinline__ float ex2(float x) { return __builtin_amdgcn_exp2f(x); }
__device__ __forceinline__ float sigm(float x) { return __builtin_amdgcn_rcpf(1.0f + ex2(-1.4426950408889634f * x)); }
__device__ __forceinline__ float silu(float x) { return x * sigm(x); }

struct EpiProj {
    static constexpr bool PERM = true, AFTER_DRAIN = false;
    bf16_t* O; const float* lb; const float* rope;
    __device__ __forceinline__ void operator()(const f32x4 (&acc)[2][2][4][2], const Unit& u, int wr, int wc, int fr, int fq) const {
        const int pn = u.pn;
        const int mode = pn < 4 ? 1 : pn < 8 ? 2 : pn < 12 ? 0 : pn < 16 ? 1 : pn < 18 ? 3 : pn < 20 ? 4 : pn < 24 ? 0 : pn < 28 ? 1 : 5;
        const int row0 = u.pm * 256 + wr * 64 + fr;
        const int col0 = pn * 256 + wc * 32 + 8 * fq;
        f32x4 lbv[2][2];
#pragma unroll
        for (int bj = 0; bj < 2; ++bj)
#pragma unroll
            for (int n = 0; n < 2; ++n) lbv[bj][n] = (mode == 2) ? *(const f32x4*)(lb + (col0 - C_HF) + bj * 128 + 4 * n) : (f32x4){0.f, 0.f, 0.f, 0.f};
#pragma unroll
        for (int ai = 0; ai < 2; ++ai)
#pragma unroll
            for (int m = 0; m < 4; ++m) {
                const int row = row0 + ai * 128 + m * 16;
                bf16_t* rowp = O + (size_t)row * DIN + col0;
                f32x4 cs0 = (f32x4){1.f, 0.f, 1.f, 0.f}, cs1 = cs0;
                if (mode == 3 || mode == 4) { const float* rp = rope + ((size_t)(row & (SEQ - 1)) * 32 + ((col0 & 63) >> 1)) * 2; cs0 = *(const f32x4*)rp; cs1 = *(const f32x4*)(rp + 4); }
#pragma unroll
                for (int bj = 0; bj < 2; ++bj) {
                    f32x4 v0 = acc[ai][bj][m][0], v1 = acc[ai][bj][m][1];
                    if (mode == 1) {
#pragma unroll
                        for (int j = 0; j < 4; ++j) { v0[j] = silu(v0[j]); v1[j] = silu(v1[j]); }
                    } else if (mode == 5) {
#pragma unroll
                        for (int j = 0; j < 4; ++j) { v0[j] = sigm(v0[j]); v1[j] = sigm(v1[j]); }
                    } else if (mode == 2) {
#pragma unroll
                        for (int j = 0; j < 4; ++j) { const float l0 = lbv[bj][0][j], l1 = lbv[bj][1][j];
                            v0[j] = __builtin_amdgcn_logf(l0 + (1.0f - l0) * sigm(v0[j])); v1[j] = __builtin_amdgcn_logf(l1 + (1.0f - l1) * sigm(v1[j])); }
                    } else if (mode == 3 || mode == 4) {
                        const float sc = (mode == 4) ? 0.125f : 1.0f;
                        f32x4 r0, r1;
                        r0[0] = (v0[0] * cs0[0] - v0[1] * cs0[1]) * sc; r0[1] = (v0[0] * cs0[1] + v0[1] * cs0[0]) * sc;
                        r0[2] = (v0[2] * cs0[2] - v0[3] * cs0[3]) * sc; r0[3] = (v0[2] * cs0[3] + v0[3] * cs0[2]) * sc;
                        r1[0] = (v1[0] * cs1[0] - v1[1] * cs1[1]) * sc; r1[1] = (v1[0] * cs1[1] + v1[1] * cs1[0]) * sc;
                        r1[2] = (v1[2] * cs1[2] - v1[3] * cs1[3]) * sc; r1[3] = (v1[2] * cs1[3] + v1[3] * cs1[2]) * sc;
                        v0 = r0; v1 = r1;
                    }
                    u32x4 w; w.x = pkbf(v0[0], v0[1]); w.y = pkbf(v0[2], v0[3]); w.z = pkbf(v1[0], v1[1]); w.w = pkbf(v1[2], v1[3]);
                    *(u32x4*)(rowp + bj * 128) = w;
                }
            }
    }
};
struct EpiRes {
    static constexpr bool PERM = false, AFTER_DRAIN = false;
    const float* x; float* out; const float* mod;
    __device__ __forceinline__ void operator()(const f32x4 (&acc)[2][2][4][2], const Unit& u, int wr, int wc, int fr, int fq) const {
        const int row0 = u.pm * 256 + wr * 64 + fr, col0 = u.pn * 256 + wc * 32 + 4 * fq;
        const int b = (u.pm * 256) / SEQ;
        const float* gate = mod + (size_t)b * 3 * D + 2 * D + col0;
        f32x4 gv[2][2];
#pragma unroll
        for (int bj = 0; bj < 2; ++bj)
#pragma unroll
            for (int n = 0; n < 2; ++n) gv[bj][n] = *(const f32x4*)(gate + bj * 128 + n * 16);
#pragma unroll
        for (int ai = 0; ai < 2; ++ai)
#pragma unroll
            for (int m = 0; m < 4; ++m) { const size_t off = (size_t)(row0 + ai * 128 + m * 16) * D + col0;
#pragma unroll
                for (int bj = 0; bj < 2; ++bj)
#pragma unroll
                    for (int n = 0; n < 2; ++n) { const f32x4 xs = *(const f32x4*)(x + off + bj * 128 + n * 16); *(f32x4*)(out + off + bj * 128 + n * 16) = xs + gv[bj][n] * acc[ai][bj][m][n]; }
                asm volatile("" ::: "memory"); }
    }
};

struct Params { const float* x; const float* c; const float* norm_g; const float* w_ada; const float* b_ada; const float* w_in; const float* lb_logits; const float* hg_norm_g;
                const float* ret_norm_g; const float* w_out; const float* final_g; float* out; unsigned char* ws; };

__device__ __forceinline__ void p0_mod(ldsp lds, const Params& p, int job) {
    const int tid = threadIdx.x, cl = tid & 63, ks = tid >> 6, n = job * 64 + cl;
    LAS float* sc = (LAS float*)lds;
    LAS float* red = (LAS float*)(lds + 32768);
    for (int i = tid; i < NB * D; i += 512) sc[i] = silu(p.c[i]);
    __syncthreads();
    float a[NB];
#pragma unroll
    for (int b = 0; b < NB; ++b) a[b] = 0.f;
    for (int k = ks * 128; k < ks * 128 + 128; ++k) { const float w = p.w_ada[(size_t)k * (3 * D) + n];
#pragma unroll
        for (int b = 0; b < NB; ++b) a[b] += sc[b * D + k] * w; }
#pragma unroll
    for (int b = 0; b < NB; ++b) red[(ks * NB + b) * 64 + cl] = a[b];
    __syncthreads();
    { const int b = tid >> 6; float s = p.b_ada[n];
#pragma unroll
      for (int q = 0; q < 8; ++q) s += red[(q * NB + b) * 64 + cl];
      ((float*)(p.ws + WS_MOD))[(size_t)b * 3 * D + n] = s; }
    __syncthreads();
}
__device__ __forceinline__ void p0_transpose(ldsp lds, const float* W, int N, bf16_t* Wt, int kt, int nt, bool permute) {
    const int tid = threadIdx.x; LAS float* t = (LAS float*)lds;
    const int nn = tid & 63; int src = nn;
    if (permute) src = (nn & 1) ? (nn >> 1) + 32 : (nn >> 1);
#pragma unroll
    for (int i = 0; i < 8; ++i) { const int kk = i * 8 + (tid >> 6); t[kk * 65 + nn] = W[(size_t)(kt * 64 + kk) * N + nt * 64 + src]; }
    __syncthreads();
    { const int n2 = tid >> 3, k8 = (tid & 7) * 8; float v[8];
#pragma unroll
      for (int i = 0; i < 8; ++i) v[i] = t[(k8 + i) * 65 + n2];
      u32x4 w; w.x = pkbf(v[0], v[1]); w.y = pkbf(v[2], v[3]); w.z = pkbf(v[4], v[5]); w.w = pkbf(v[6], v[7]);
      *(u32x4*)(Wt + (size_t)(nt * 64 + n2) * D + kt * 64 + k8) = w; }
    __syncthreads();
}
__device__ __forceinline__ void sincos_d(double r, double& s, double& c) {
    const double r2 = r * r; double cs = 1.0, sn = 1.0;
    double tc = 1.0, ts = 1.0;
#pragma unroll
    for (int k = 1; k <= 13; ++k) { tc *= -r2 / (double)((2 * k - 1) * (2 * k)); ts *= -r2 / (double)((2 * k) * (2 * k + 1)); cs += tc; sn += ts; }
    c = cs; s = sn * r;
}
__device__ __forceinline__ void p0_tables(const Params& p) {
    const int gt = blockIdx.x * 512 + threadIdx.x, gs = gridDim.x * 512;
    float* lb = (float*)(p.ws + WS_LB); float* rope = (float*)(p.ws + WS_ROPE);
    for (int i = gt; i < D; i += gs) { const float l0 = p.lb_logits[i], l1 = p.lb_logits[D + i]; const float mx = fmaxf(l0, l1); const float e0 = __expf(l0 - mx), e1 = __expf(l1 - mx); lb[i] = e0 / (e0 + e1); }
    for (int i = gt; i < SEQ * 32; i += gs) { const int pos = i >> 5, j = i & 31;
        const float ex = (float)j * (1.0f / 31.0f);
        const float invf = 1.0f / (float)exp((double)ex * 9.210340371976184);
        const float ang = (float)pos * invf;
        const double a = (double)ang; const double n = rint(a * 0.15915494309189535); const double r = fma(-n, 6.283185307179586, a) - n * 2.4492935982947064e-16;
        double s, c; sincos_d(r, s, c);
        rope[2 * i] = (float)c; rope[2 * i + 1] = (float)s; }
}
__device__ __forceinline__ void p0_hnorm(const Params& p) {
    const int lane = threadIdx.x & 63, wave = threadIdx.x >> 6;
    const float* mod = (const float*)(p.ws + WS_MOD); bf16_t* H = (bf16_t*)(p.ws + WS_H);
    for (int row = blockIdx.x * 8 + wave; row < MTOT; row += gridDim.x * 8) {
        const float* xr = p.x + (size_t)row * D; const int b = row / SEQ;
        f32x4 v[4]; float ss = 0.f;
#pragma unroll
        for (int i = 0; i < 4; ++i) { v[i] = *(const f32x4*)(xr + i * 256 + lane * 4); ss += v[i][0] * v[i][0] + v[i][1] * v[i][1] + v[i][2] * v[i][2] + v[i][3] * v[i][3]; }
#pragma unroll
        for (int o = 1; o < 64; o <<= 1) ss += __shfl_xor(ss, o);
        const float rstd = rsqrtf(ss * (1.0f / D) + EPS);
#pragma unroll
        for (int i = 0; i < 4; ++i) { const int c0 = i * 256 + lane * 4;
            const f32x4 g = *(const f32x4*)(p.norm_g + c0), sh = *(const f32x4*)(mod + (size_t)b * 3 * D + c0), sc = *(const f32x4*)(mod + (size_t)b * 3 * D + D + c0);
            const f32x4 hv = v[i] * rstd * g * (sc + 1.0f) + sh;
            u32x2 w; w.x = pkbf(hv[0], hv[1]); w.y = pkbf(hv[2], hv[3]);
            *(u32x2*)(H + (size_t)row * D + c0) = w; }
    }
}
__device__ __forceinline__ void p4_final(const Params& p) {
    const int lane = threadIdx.x & 63, wave = threadIdx.x >> 6;
    for (int row = blockIdx.x * 8 + wave; row < MTOT; row += gridDim.x * 8) {
        float* xr = p.out + (size_t)row * D;
        f32x4 v[4]; float ss = 0.f;
#pragma unroll
        for (int i = 0; i < 4; ++i) { v[i] = *(const f32x4*)(xr + i * 256 + lane * 4); ss += v[i][0] * v[i][0] + v[i][1] * v[i][1] + v[i][2] * v[i][2] + v[i][3] * v[i][3]; }
#pragma unroll
        for (int o = 1; o < 64; o <<= 1) ss += __shfl_xor(ss, o);
        const float rstd = rsqrtf(ss * (1.0f / D) + EPS);
#pragma unroll
        for (int i = 0; i < 4; ++i) { const int c0 = i * 256 + lane * 4; const f32x4 g = *(const f32x4*)(p.final_g + c0); *(f32x4*)(xr + c0) = v[i] * rstd * g; }
    }
}

template <bool OUT>
__device__ __forceinline__ void prep_hg(const int tid, ldsp lds, const bf16_t* P, int h, float& gs0, float& gs1) {
    const int dp = tid & 63, sub = tid >> 6, d = 2 * dp;
    const unsigned voff = (unsigned)(((8 * sub) * DIN + h * 128 + d) * 2);
    unsigned qv[8], gv[8], vv[8];
#pragma unroll
    for (int i = 0; i < 8; ++i) { const char* rb = (const char*)P + (size_t)i * (DIN * 2);
        qv[i] = OUT ? *(const unsigned*)(rb + C_HQ * 2 + voff) : 0u; gv[i] = *(const unsigned*)(rb + C_HF * 2 + voff); vv[i] = *(const unsigned*)(rb + C_HI * 2 + voff); }
    float b0[8], b1[8]; float r0 = 0.f, r1 = 0.f;
#pragma unroll
    for (int i = 0; i < 8; ++i) { r0 += bflo(gv[i]); b0[i] = r0; r1 += bfhi(gv[i]); b1[i] = r1; }
    LAS float* SUB = (LAS float*)(lds + L_SUB);
    *(LAS f32x2v*)(SUB + sub * 128 + d) = (f32x2v){r0, r1};
    __syncthreads();
    float p0 = 0.f, p1 = 0.f, m0 = 0.f, m1 = 0.f, t0 = 0.f, t1 = 0.f;
#pragma unroll
    for (int s = 0; s < 8; ++s) { const f32x2v x = *(const LAS f32x2v*)(SUB + s * 128 + d);
        if (s < sub) { p0 += x.x; p1 += x.y; } if (s < 4) { m0 += x.x; m1 += x.y; } t0 += x.x; t1 += x.y; }
    if (sub == 0) { LAS float* EM = (LAS float*)(lds + L_EM); EM[d] = ex2(m0); EM[d + 1] = ex2(m1); EM[128 + d] = ex2(t0 - m0); EM[128 + d + 1] = ex2(t1 - m1); }
    gs0 += t0; gs1 += t1;
    unsigned kt0[4], kt1[4], vt0[4], vt1[4]; float kp0 = 0.f, kp1 = 0.f;
#pragma unroll
    for (int i = 0; i < 8; ++i) { const int t = 8 * sub + i;
        const float x0 = fminf(fmaxf(p0 + b0[i] - m0, -115.f), 115.f), x1 = fminf(fmaxf(p1 + b1[i] - m1, -115.f), 115.f);
        const float k0 = (1.0f - ex2(bflo(gv[i]))) * ex2(-x0), k1 = (1.0f - ex2(bfhi(gv[i]))) * ex2(-x1);
        if (OUT) { *(LAS unsigned*)(lds + L_QT + t * RS_D + d * 2) = pkbf(bflo(qv[i]) * ex2(x0), bfhi(qv[i]) * ex2(x1));
                   *(LAS unsigned*)(lds + L_KT + t * RS_D + d * 2) = pkbf(k0, k1); }
        if (i & 1) { kt0[i >> 1] = pkbf(kp0, k0); kt1[i >> 1] = pkbf(kp1, k1);
                     vt0[i >> 1] = (vv[i - 1] & 0xffffu) | (vv[i] << 16); vt1[i >> 1] = (vv[i - 1] >> 16) | (vv[i] & 0xffff0000u); }
        else { kp0 = k0; kp1 = k1; } }
    *(LAS u32x4*)(lds + L_KTT + d * RS_S + sub * 16) = (u32x4){kt0[0], kt0[1], kt0[2], kt0[3]};
    *(LAS u32x4*)(lds + L_KTT + (d + 1) * RS_S + sub * 16) = (u32x4){kt1[0], kt1[1], kt1[2], kt1[3]};
    *(LAS u32x4*)(lds + L_VT + d * RS_S + sub * 16) = (u32x4){vt0[0], vt0[1], vt0[2], vt0[3]};
    *(LAS u32x4*)(lds + L_VT + (d + 1) * RS_S + sub * 16) = (u32x4){vt1[0], vt1[1], vt1[2], vt1[3]};
}
template <bool OUT>
__device__ __forceinline__ void prep_rt(const int tid, ldsp lds, const bf16_t* P, int h, float lg) {
    { const int dp = tid & 31, sub = tid >> 5, d = 2 * dp;
      const unsigned voff = (unsigned)(((4 * sub) * DIN + h * 64 + d) * 2);
      unsigned qv[4], kv[4];
#pragma unroll
      for (int i = 0; i < 4; ++i) { const char* rb = (const char*)P + (size_t)i * (DIN * 2);
          qv[i] = OUT ? *(const unsigned*)(rb + C_RQ * 2 + voff) : 0u; kv[i] = *(const unsigned*)(rb + C_RK * 2 + voff); }
      unsigned kt0[2], kt1[2]; float kp0 = 0.f, kp1 = 0.f;
#pragma unroll
      for (int i = 0; i < 4; ++i) { const int t = 4 * sub + i; const float ek = ex2((float)(31 - t) * lg);
          const float k0 = bflo(kv[i]) * ek, k1 = bfhi(kv[i]) * ek;
          if (OUT) { const float eq = ex2((float)(t - 31) * lg);
                     *(LAS unsigned*)(lds + L_QT + t * RS_D + d * 2) = pkbf(bflo(qv[i]) * eq, bfhi(qv[i]) * eq);
                     *(LAS unsigned*)(lds + L_KT + t * RS_D + d * 2) = pkbf(k0, k1); }
          if (i & 1) { kt0[i >> 1] = pkbf(kp0, k0); kt1[i >> 1] = pkbf(kp1, k1); } else { kp0 = k0; kp1 = k1; } }
      *(LAS u32x2*)(lds + L_KTT + d * RS_S + sub * 8) = (u32x2){kt0[0], kt0[1]};
      *(LAS u32x2*)(lds + L_KTT + (d + 1) * RS_S + sub * 8) = (u32x2){kt1[0], kt1[1]}; }
    { const int ep = tid & 63, sub = tid >> 6, e = 2 * ep;
      const unsigned voff = (unsigned)(((8 * sub) * DIN + h * 128 + e) * 2);
      unsigned vv[8], vt0[4], vt1[4];
#pragma unroll
      for (int i = 0; i < 8; ++i) vv[i] = *(const unsigned*)((const char*)P + (size_t)i * (DIN * 2) + C_RV * 2 + voff);
#pragma unroll
      for (int i = 0; i < 4; ++i) { vt0[i] = (vv[2 * i] & 0xffffu) | (vv[2 * i + 1] << 16); vt1[i] = (vv[2 * i] >> 16) | (vv[2 * i + 1] & 0xffff0000u); }
      *(LAS u32x4*)(lds + L_VT + e * RS_S + sub * 16) = (u32x4){vt0[0], vt0[1], vt0[2], vt0[3]};
      *(LAS u32x4*)(lds + L_VT + (e + 1) * RS_S + sub * 16) = (u32x4){vt1[0], vt1[1], vt1[2], vt1[3]}; }
    if (tid < 64) { const float e32 = ex2(32.0f * lg); LAS float* EM = (LAS float*)(lds + L_EM); EM[tid] = e32; EM[128 + tid] = e32; }
}
template <int DK, bool OUT>
__device__ __forceinline__ void mix_core(const int tid, ldsp lds, f32x4 (&S)[DK == 128 ? 8 : 4]) {
    constexpr int NE = DK == 128 ? 8 : 4;
    const int w = __builtin_amdgcn_readfirstlane(tid >> 6), lane = tid & 63, l15 = lane & 15, quad = lane >> 4;
    const int db = DK == 128 ? w : (w & 3), eb0 = DK == 128 ? 0 : (w >> 2) * 4;
    __syncthreads();
    { const f32x4 em4 = *(const LAS f32x4*)(lds + L_EM + (db * 16 + quad * 4) * 4);
#pragma unroll
      for (int i = 0; i < NE; ++i) S[i] *= em4; }
    if (OUT) {
#pragma unroll
        for (int i = 0; i < NE; ++i) *(LAS u32x2*)(lds + L_SM + ((eb0 + i) * 16 + l15) * RS_D + (db * 16 + quad * 4) * 2) = (u32x2){pkbf(S[i][0], S[i][1]), pkbf(S[i][2], S[i][3])};
        const int tb = w & 3;
#pragma unroll
        for (int si = 0; si < 2; ++si) { const int sb = (w >> 2) * 2 + si; f32x4 a = (f32x4){0.f, 0.f, 0.f, 0.f};
            if (sb <= tb) {
#pragma unroll
                for (int ks = 0; ks < DK / 32; ++ks) { const bf16x8 af = *(const LAS bf16x8*)(lds + L_QT + (tb * 16 + l15) * RS_D + (ks * 32 + quad * 8) * 2);
                    const bf16x8 bf = *(const LAS bf16x8*)(lds + L_KT + (sb * 16 + l15) * RS_D + (ks * 32 + quad * 8) * 2);
                    a = __builtin_amdgcn_mfma_f32_16x16x32_bf16(af, bf, a, 0, 0, 0); }
            }
#pragma unroll
            for (int j = 0; j < 4; ++j) { const int t = tb * 16 + quad * 4 + j, s = sb * 16 + l15; const float v = (s <= t) ? a[j] : 0.f;
                *(LAS unsigned short*)(lds + L_AM + t * RS_S + s * 2) = (unsigned short)(pkbf(v, 0.f) & 0xffffu); }
        }
        __syncthreads();
        f32x4 o[4];
#pragma unroll
        for (int i = 0; i < 4; ++i) o[i] = (f32x4){0.f, 0.f, 0.f, 0.f};
        const int oe0 = (w >> 2) * 4;
#pragma unroll
        for (int ks = 0; ks < DK / 32; ++ks) { const bf16x8 af = *(const LAS bf16x8*)(lds + L_QT + (tb * 16 + l15) * RS_D + (ks * 32 + quad * 8) * 2);
#pragma unroll
            for (int i = 0; i < 4; ++i) { const bf16x8 bf = *(const LAS bf16x8*)(lds + L_SM + ((oe0 + i) * 16 + l15) * RS_D + (ks * 32 + quad * 8) * 2);
                o[i] = __builtin_amdgcn_mfma_f32_16x16x32_bf16(af, bf, o[i], 0, 0, 0); }
            __builtin_amdgcn_sched_barrier(0); }
#pragma unroll
        for (int ks = 0; ks < 2; ++ks) { const bf16x8 af = *(const LAS bf16x8*)(lds + L_AM + (tb * 16 + l15) * RS_S + (ks * 32 + quad * 8) * 2);
#pragma unroll
            for (int i = 0; i < 4; ++i) { const bf16x8 bf = *(const LAS bf16x8*)(lds + L_VT + ((oe0 + i) * 16 + l15) * RS_S + (ks * 32 + quad * 8) * 2);
                o[i] = __builtin_amdgcn_mfma_f32_16x16x32_bf16(af, bf, o[i], 0, 0, 0); }
            __builtin_amdgcn_sched_barrier(0); }
#pragma unroll
        for (int i = 0; i < 4; ++i)
#pragma unroll
            for (int j = 0; j < 4; ++j) *(LAS float*)(lds + L_OF + (tb * 16 + quad * 4 + j) * RS_O + ((oe0 + i) * 16 + l15) * 4) = o[i][j];
    }
#pragma unroll
    for (int ks = 0; ks < 2; ++ks) { const bf16x8 af = *(const LAS bf16x8*)(lds + L_KTT + (db * 16 + l15) * RS_S + (ks * 32 + quad * 8) * 2);
#pragma unroll
        for (int i = 0; i < NE; ++i) { const bf16x8 bf = *(const LAS bf16x8*)(lds + L_VT + ((eb0 + i) * 16 + l15) * RS_S + (ks * 32 + quad * 8) * 2);
            S[i] = __builtin_amdgcn_mfma_f32_16x16x32_bf16(af, bf, S[i], 0, 0, 0); }
        __builtin_amdgcn_sched_barrier(0); }
    { const f32x4 ed4 = *(const LAS f32x4*)(lds + L_EM + (128 + db * 16 + quad * 4) * 4);
#pragma unroll
      for (int i = 0; i < NE; ++i) S[i] *= ed4; }
    __syncthreads();
}
__device__ __forceinline__ void epi_mix(const int tid, ldsp lds, const bf16_t* Prow, int zcol, int gcol, const float* gn, float (&am)[16], bool first) {
    const int t = tid >> 3, c = tid & 7;
    f32x4 o[4]; float ss = 0.f;
#pragma unroll
    for (int i = 0; i < 4; ++i) { o[i] = *(const LAS f32x4*)(lds + L_OF + t * RS_O + c * 64 + i * 16); ss += o[i][0] * o[i][0] + o[i][1] * o[i][1] + o[i][2] * o[i][2] + o[i][3] * o[i][3]; }
    ss += __shfl_xor(ss, 1); ss += __shfl_xor(ss, 2); ss += __shfl_xor(ss, 4);
    const float rstd = rsqrtf(ss * (1.0f / 128.0f) + EPS);
    const unsigned voff = (unsigned)((t * DIN + 16 * c) * 2);
    const u32x4 z0 = *(const u32x4*)((const char*)Prow + zcol * 2 + voff), z1 = *(const u32x4*)((const char*)Prow + zcol * 2 + 16 + voff);
    const u32x4 g0 = *(const u32x4*)((const char*)Prow + gcol * 2 + voff), g1 = *(const u32x4*)((const char*)Prow + gcol * 2 + 16 + voff);
#pragma unroll
    for (int i = 0; i < 4; ++i) { const f32x4 gg = *(const f32x4*)(gn + 16 * c + 4 * i);
        const unsigned zw0 = i < 2 ? z0[2 * i] : z1[2 * i - 4], zw1 = i < 2 ? z0[2 * i + 1] : z1[2 * i - 3];
        const unsigned gw0 = i < 2 ? g0[2 * i] : g1[2 * i - 4], gw1 = i < 2 ? g0[2 * i + 1] : g1[2 * i - 3];
        const float v0 = o[i][0] * rstd * gg[0] * bflo(zw0) * bflo(gw0), v1 = o[i][1] * rstd * gg[1] * bfhi(zw0) * bfhi(gw0);
        const float v2 = o[i][2] * rstd * gg[2] * bflo(zw1) * bflo(gw1), v3 = o[i][3] * rstd * gg[3] * bfhi(zw1) * bfhi(gw1);
        if (first) { am[4 * i] = v0; am[4 * i + 1] = v1; am[4 * i + 2] = v2; am[4 * i + 3] = v3; }
        else { am[4 * i] += v0; am[4 * i + 1] += v1; am[4 * i + 2] += v2; am[4 * i + 3] += v3; } }
}

__device__ __forceinline__ void p2a(ldsp lds, const Params& p) {
    const bf16_t* proj = (const bf16_t*)(p.ws + WS_PROJ);
    int tid_ = threadIdx.x; asm volatile("" : "+v"(tid_)); const int tid = tid_;
    for (int u = blockIdx.x; u < 256; u += gridDim.x) {
        const int seg = u & 7, h = (u >> 3) & 7, bl = u >> 6;
        if (seg == NSEG - 1) continue;
        const float lg = log1pf(-exp2f(-5.0f - (float)h)) * 1.4426950408889634f;
        f32x4 SA[8], SB[4];
#pragma unroll
        for (int i = 0; i < 8; ++i) SA[i] = (f32x4){0.f, 0.f, 0.f, 0.f};
#pragma unroll
        for (int i = 0; i < 4; ++i) SB[i] = (f32x4){0.f, 0.f, 0.f, 0.f};
        float gs0 = 0.f, gs1 = 0.f;
        const size_t row0 = (size_t)bl * SEQ + (size_t)seg * SEGLEN;
        for (int c = 0; c < NCH; ++c) { const bf16_t* P = proj + (row0 + (size_t)c * 64) * DIN;
            prep_hg<false>(tid, lds, P, h, gs0, gs1); mix_core<128, false>(tid, lds, SA);
            prep_rt<false>(tid, lds, P, h, lg);       mix_core<64, false>(tid, lds, SB); }
        float* sla = (float*)(p.ws + WS_SLA) + (size_t)u * 16384; float* slb = (float*)(p.ws + WS_SLB) + (size_t)u * 8192; float* da = (float*)(p.ws + WS_DA) + (size_t)u * 128;
#pragma unroll
        for (int i = 0; i < 8; ++i) *(f32x4*)((char*)sla + (unsigned)(tid * 128 + i * 16)) = SA[i];
#pragma unroll
        for (int i = 0; i < 4; ++i) *(f32x4*)((char*)slb + (unsigned)(tid * 64 + i * 16)) = SB[i];
        if (tid < 64) { da[2 * tid] = ex2(gs0); da[2 * tid + 1] = ex2(gs1); }
    }
}
__device__ __forceinline__ void p2b(ldsp lds, const Params& p, int half) {
    const bf16_t* proj = (const bf16_t*)(p.ws + WS_PROJ);
    bf16_t* Mo = (bf16_t*)(p.ws + WS_H) + (size_t)half * MH * D;
    int tid_ = threadIdx.x; asm volatile("" : "+v"(tid_)); const int tid = tid_, w = __builtin_amdgcn_readfirstlane(tid >> 6), lane = tid & 63, quad = lane >> 4;
    for (int u = blockIdx.x; u < 256; u += gridDim.x) {
        const int seg = u & 7, h = (u >> 3) & 7, bl = u >> 6;
        const float lg = log1pf(-exp2f(-5.0f - (float)h)) * 1.4426950408889634f;
        const float dB = ex2((float)SEGLEN * lg);
        f32x4 SA[8], SB[4];
#pragma unroll
        for (int i = 0; i < 8; ++i) SA[i] = (f32x4){0.f, 0.f, 0.f, 0.f};
#pragma unroll
        for (int i = 0; i < 4; ++i) SB[i] = (f32x4){0.f, 0.f, 0.f, 0.f};
        for (int s = 0; s < seg; ++s) { const int uu = u - seg + s;
            const float* sla = (const float*)(p.ws + WS_SLA) + (size_t)uu * 16384; const float* slb = (const float*)(p.ws + WS_SLB) + (size_t)uu * 8192;
            const f32x4 d4 = *(const f32x4*)((const float*)(p.ws + WS_DA) + (size_t)uu * 128 + w * 16 + quad * 4);
#pragma unroll
            for (int i = 0; i < 8; ++i) SA[i] = SA[i] * d4 + *(const f32x4*)((const char*)sla + (unsigned)(tid * 128 + i * 16));
#pragma unroll
            for (int i = 0; i < 4; ++i) SB[i] = SB[i] * dB + *(const f32x4*)((const char*)slb + (unsigned)(tid * 64 + i * 16)); }
        float gs0 = 0.f, gs1 = 0.f;
        const size_t row0 = (size_t)bl * SEQ + (size_t)seg * SEGLEN;
        const int t = tid >> 3, c8 = tid & 7;
        for (int c = 0; c < NCH; ++c) { const bf16_t* P = proj + (row0 + (size_t)c * 64) * DIN;
            float am[16];
            prep_hg<true>(tid, lds, P, h, gs0, gs1); mix_core<128, true>(tid, lds, SA);
            epi_mix(tid, lds, P + h * 128, C_HZ, C_GA, p.hg_norm_g + h * 128, am, true);
            prep_rt<true>(tid, lds, P, h, lg);       mix_core<64, true>(tid, lds, SB);
            epi_mix(tid, lds, P + h * 128, C_RZ, C_GB, p.ret_norm_g + h * 128, am, false);
            bf16_t* mo = Mo + (row0 + (size_t)c * 64 + t) * D + h * 128 + 16 * c8;
            *(u32x4*)mo = (u32x4){pkbf(am[0], am[1]), pkbf(am[2], am[3]), pkbf(am[4], am[5]), pkbf(am[6], am[7])};
            *(u32x4*)(mo + 8) = (u32x4){pkbf(am[8], am[9]), pkbf(am[10], am[11]), pkbf(am[12], am[13]), pkbf(am[14], am[15])};
        }
    }
}

#ifndef REP_P0A
#define REP_P0A 1
#endif
#ifndef REP_P0B
#define REP_P0B 1
#endif
#ifndef REP_P3
#define REP_P3 1
#endif
#ifndef REP_P1
#define REP_P1 1
#endif
#ifndef REP_P2A
#define REP_P2A 1
#endif
#ifndef REP_P2B
#define REP_P2B 1
#endif
__global__ void __launch_bounds__(512, 2) fwd_megakernel(Params p) {
    extern __shared__ __attribute__((aligned(16))) unsigned char lds_raw[];
    ldsp lds = (ldsp)lds_raw;
    cg::grid_group grid = cg::this_grid();
    const int G = gridDim.x;
    for (int r_ = 0; r_ < REP_P0A; ++r_) {
    for (int j = blockIdx.x; j < 48; j += G) p0_mod(lds, p, j);
    p0_tables(p);
    for (int tI = blockIdx.x; tI < 144 * 16 + 16 * 16; tI += G) {
        if (tI < 144 * 16) { const int nt = tI / 16, kt = tI % 16; p0_transpose(lds, p.w_in, DIN, (bf16_t*)(p.ws + WS_WIN), kt, nt, nt >= C_RQ / 64 && nt < C_RV / 64); }
        else { const int q = tI - 144 * 16; p0_transpose(lds, p.w_out, D, (bf16_t*)(p.ws + WS_WOUT), q % 16, q / 16, false); }
    }
    grid.sync(); }
    for (int r_ = 0; r_ < REP_P0B; ++r_) p0_hnorm(p);
    grid.sync();
    for (int half = 0; half < 2; ++half) {
        for (int r_ = 0; r_ < REP_P1; ++r_) { pg8::Gemm g{(const bf16_t*)(p.ws + WS_H) + (size_t)half * MH * D, (const bf16_t*)(p.ws + WS_WIN), MH, DIN, D};
          pg8::StaticOrder S; S.init(MH, DIN, G, (int)blockIdx.x);
          EpiProj E{(bf16_t*)(p.ws + WS_PROJ), (const float*)(p.ws + WS_LB), (const float*)(p.ws + WS_ROPE)};
          pg8::gemm_phase<EpiProj, pg8::StaticOrder, false>(lds, g, S, E, nullptr); if (r_ + 1 < REP_P1) grid.sync(); }
        grid.sync();
        for (int r_ = 0; r_ < REP_P2A; ++r_) { p2a(lds, p); if (r_ + 1 < REP_P2A) grid.sync(); }
        grid.sync();
        for (int r_ = 0; r_ < REP_P2B; ++r_) { p2b(lds, p, half); if (r_ + 1 < REP_P2B) grid.sync(); }
        grid.sync();
    }
    for (int r_ = 0; r_ < REP_P3; ++r_) { pg8::Gemm g{(const bf16_t*)(p.ws + WS_H), (const bf16_t*)(p.ws + WS_WOUT), MTOT, D, D};
      pg8::StaticOrder S; S.init(MTOT, D, G, (int)blockIdx.x);
      EpiRes E{p.x, p.out, (const float*)(p.ws + WS_MOD)};
      pg8::gemm_phase<EpiRes, pg8::StaticOrder, false>(lds, g, S, E, nullptr); if (r_ + 1 < REP_P3) grid.sync(); }
    grid.sync();
    p4_final(p);
}

extern "C" void kernel_launch(void* const* d_in, const int* in_sizes, int n_in, void* d_out, int out_size, void* d_ws, size_t ws_size, hipStream_t stream) {
    static int grid = 0;
    if (grid == 0) {
        if (n_in != 11 || out_size != MTOT * D || ws_size < WS_END) { fprintf(stderr, "kernel_launch: unexpected shapes (n_in %d out %d ws %zu)\n", n_in, out_size, ws_size); grid = -1; return; }
        int dev = 0, cus = 0, per_cu = 0;
        hipGetDevice(&dev); hipDeviceGetAttribute(&cus, hipDeviceAttributeMultiprocessorCount, dev);
        if (hipFuncSetAttribute((const void*)fwd_megakernel, hipFuncAttributeMaxDynamicSharedMemorySize, LDS_BYTES) != hipSuccess) { fprintf(stderr, "kernel_launch: hipFuncSetAttribute failed\n"); grid = -1; return; }
        if (hipOccupancyMaxActiveBlocksPerMultiprocessor(&per_cu, (const void*)fwd_megakernel, 512, LDS_BYTES) != hipSuccess || per_cu < 1) { fprintf(stderr, "kernel_launch: occupancy query failed (%d)\n", per_cu); per_cu = 1; }
        (void)hipGetLastError();
        grid = cus;
        fprintf(stderr, "kernel_launch: cus %d per_cu %d grid %d\n", cus, per_cu, grid);
    }
    if (grid < 0) return;
    Params p{};
    p.x = (const float*)d_in[0]; p.c = (const float*)d_in[1]; p.norm_g = (const float*)d_in[2]; p.w_ada = (const float*)d_in[3]; p.b_ada = (const float*)d_in[4];
    p.w_in = (const float*)d_in[5]; p.lb_logits = (const float*)d_in[6]; p.hg_norm_g = (const float*)d_in[7]; p.ret_norm_g = (const float*)d_in[8]; p.w_out = (const float*)d_in[9];
    p.final_g = (const float*)d_in[10]; p.out = (float*)d_out; p.ws = (unsigned char*)d_ws;
    void* args[] = {&p};
    hipError_t e = hipLaunchCooperativeKernel((const void*)fwd_megakernel, dim3(grid), dim3(512), args, LDS_BYTES, stream);
    if (e != hipSuccess) fprintf(stderr, "kernel_launch: cooperative launch failed: %s (grid %d)\n", hipGetErrorString(e), grid);
}
```

```cpp
#include <hip/hip_runtime.h>
#include <hip/hip_cooperative_groups.h>
#include <cstdio>
namespace cg = cooperative_groups;
#define LAS __attribute__((address_space(3)))
namespace pg8 {
#define PG8_LAS __attribute__((address_space(3)))
typedef unsigned short bf16_t;
typedef short bf16x8 __attribute__((ext_vector_type(8)));
typedef float f32x4 __attribute__((ext_vector_type(4)));
typedef unsigned u32x4 __attribute__((ext_vector_type(4)));
constexpr int BM = 256, BK = 64, HALF = 128, HTB = HALF * BK * 2  , STAGE_BYTES = 8 * HTB, NXCD = 8, WGM = 8;

__host__ __device__ __forceinline__ int lds_byte(int r, int c) { const int st = (r >> 4) * 2 + (c >> 5), rr = r & 15, cc = c & 31, ob = rr * 64 + cc * 2; return st * 1024 + (ob ^ (((ob >> 9) & 1) << 5)); }
__host__ __device__ __forceinline__ void stage_rc(int b, int& R, int& C) { const int st = b / 1024, sb = b % 1024, swz = sb ^ (((sb >> 9) & 1) << 5); R = (st >> 1) * 16 + swz / 64; C = (st & 1) * 32 + (swz % 64) / 2; }
__host__ __device__ __forceinline__ int perm32(int rho) { const int n = rho >> 4, i = rho & 15; return 8 * (i >> 2) + 4 * n + (i & 3); }

struct Unit { int pm, pn; };
struct Gemm { const bf16_t* A; const bf16_t* Bt; int M, N, K; };
struct StaticOrder {
    int nM, nN, nwg, G, c;
    __host__ __device__ void init(int M, int N, int G_, int c_) { nM = M / BM; nN = N / BM; nwg = nM * nN; G = G_; c = c_; }
    __host__ __device__ bool next(int i, Unit& u) const {
        const long L = (long)i * G + c; if (L >= nwg) return false;
        int wgid = (int)L; { const int q = nwg / NXCD, r = nwg % NXCD, xcd = wgid % NXCD, off = wgid / NXCD; wgid = (xcd < r ? xcd * (q + 1) : r * (q + 1) + (xcd - r) * q) + off; }
        const int nig = WGM * nN, gid = wgid / nig, fm = gid * WGM, gsz = (nM - fm) < WGM ? (nM - fm) : WGM;
        u.pm = fm + ((wgid % nig) % gsz); u.pn = (wgid % nig) / gsz; return true;
    }
    __device__ __forceinline__ void a_ready(const Unit&) const {}
    __device__ __forceinline__ void done(const Unit&) const {}
};
__device__ __forceinline__ unsigned cvt_pk_bf16(float lo, float hi) { unsigned r; asm volatile("v_cvt_pk_bf16_f32 %0, %1, %2" : "=v"(r) : "v"(lo), "v"(hi)); return r; }
typedef float f32x2 __attribute__((ext_vector_type(2)));
template <class Epi, class Sched, bool STAMP = false>
__device__ __forceinline__ void gemm_phase(PG8_LAS unsigned char* lds, const Gemm g, const Sched& S, const Epi& E, unsigned long long* stamps) {
    int tid_ = threadIdx.x; asm volatile("" : "+v"(tid_)); const int tid = tid_, wid = __builtin_amdgcn_readfirstlane(tid >> 6), lane = tid & 63, wr = wid >> 2, wc = wid & 3, fr = lane & 15, fq = lane >> 4;
    const int K = g.K, nt = K / BK;
    int ts_lo = 0, ts_hi = 0, nts = 0; const unsigned long long rt_entry = STAMP ? (unsigned long long)wall_clock64() : 0ull;
#define PG8_STAMP() do { if (STAMP && wid == 0 && nts < 64) { const unsigned long long _c = (unsigned long long)clock64(); \
        ts_lo = (lane == nts) ? (int)(unsigned)_c : ts_lo; ts_hi = (lane == nts) ? (int)(unsigned)(_c >> 32) : ts_hi; ++nts; } } while (0)
    PG8_STAMP();
    unsigned voffA[2], voffB[2];
#pragma unroll
    for (int i = 0; i < 2; ++i) { int R, C; stage_rc(tid * 16 + i * 8192, R, C); const int Rb = Epi::PERM ? ((R & ~31) + perm32(R & 31)) : R;
        voffA[i] = (unsigned)(R * K + C) * 2u; voffB[i] = (unsigned)(Rb * K + C) * 2u; }
    const size_t kstep = (size_t)(BK * 2);
    const size_t hstep = (size_t)HALF * K * 2;
    const size_t tstep = 2 * hstep;
    const unsigned ldsw = (unsigned)wid * 1024u;
    const int aoff = lds_byte(wr * 64 + fr, fq * 8), boff = lds_byte(wc * 32 + fr, fq * 8);
#define PG8_SA(b, h) (((b) * 2 + (h)) * HTB)
#define PG8_SB(b, h) ((4 + (b) * 2 + (h)) * HTB)
#define PG8_STAGE(bufoff, gbase, voff) do { _Pragma("unroll") for (int _i = 0; _i < 2; ++_i) \
        __builtin_amdgcn_global_load_lds((const unsigned*)((const char*)(gbase) + (voff)[_i]), (PG8_LAS unsigned*)(lds + (bufoff) + ldsw + _i * 8192), 16, 0, 0); } while (0)
#define PG8_LDA(dst, b, h) do { _Pragma("unroll") for (int m = 0; m < 4; ++m) _Pragma("unroll") for (int k = 0; k < 2; ++k) dst[m][k] = *(const PG8_LAS bf16x8*)(lds + PG8_SA(b, h) + aoff + m * 2048 + k * 1024); } while (0)
#define PG8_LDB(dst, b, h) do { _Pragma("unroll") for (int n = 0; n < 2; ++n) _Pragma("unroll") for (int k = 0; k < 2; ++k) dst[n][k] = *(const PG8_LAS bf16x8*)(lds + PG8_SB(b, h) + boff + n * 2048 + k * 1024); } while (0)
#define PG8_MMA(ai, bj, At, Bt) do { __builtin_amdgcn_s_setprio(1); _Pragma("unroll") for (int m = 0; m < 4; ++m) _Pragma("unroll") for (int n = 0; n < 2; ++n) _Pragma("unroll") for (int k = 0; k < 2; ++k) \
        acc[ai][bj][m][n] = __builtin_amdgcn_mfma_f32_16x16x32_bf16(Bt[n][k], At[m][k], acc[ai][bj][m][n], 0, 0, 0); __builtin_amdgcn_s_setprio(0); } while (0)
#define PG8_WAIT_V(n) asm volatile("s_waitcnt vmcnt(" #n ")" ::: "memory")
#define PG8_WAIT_L(n) asm volatile("s_waitcnt lgkmcnt(" #n ")" ::: "memory")
#define PG8_BAR __builtin_amdgcn_s_barrier()
#define PG8_SCHED __builtin_amdgcn_sched_barrier(0)
    Unit cur, nxt; int ui = 0;
    if (!S.next(0, cur)) return;
    f32x4 acc[2][2][4][2];
#pragma unroll
    for (int a = 0; a < 2; ++a)
#pragma unroll
        for (int b = 0; b < 2; ++b)
#pragma unroll
            for (int m = 0; m < 4; ++m)
#pragma unroll
                for (int n = 0; n < 2; ++n) acc[a][b][m][n] = (f32x4){0.f, 0.f, 0.f, 0.f};
    bf16x8 At[4][2], B0[2][2], B1[2][2];
    const char* cA = (const char*)g.A + (size_t)cur.pm * tstep; const char* cB = (const char*)g.Bt + (size_t)cur.pn * tstep;
    S.a_ready(cur);
    PG8_STAGE(PG8_SB(0, 0), cB, voffB); PG8_STAGE(PG8_SA(0, 0), cA, voffA); PG8_STAGE(PG8_SB(0, 1), cB + hstep, voffB); PG8_STAGE(PG8_SA(0, 1), cA + hstep, voffA);
    if (wr == 1) PG8_BAR;
    PG8_WAIT_V(4); PG8_BAR;
    PG8_STAGE(PG8_SB(1, 0), cB + kstep, voffB); PG8_STAGE(PG8_SA(1, 0), cA + kstep, voffA); PG8_STAGE(PG8_SB(1, 1), cB + hstep + kstep, voffB);
    PG8_WAIT_V(6); PG8_BAR;
    PG8_STAMP();
    for (;;) {
        const bool has_next = S.next(ui + 1, nxt);
        const char* nA = has_next ? (const char*)g.A + (size_t)nxt.pm * tstep : cA; const char* nB = has_next ? (const char*)g.Bt + (size_t)nxt.pn * tstep : cB;
        for (int t = 0; t < nt; t += 2) {
            const bool last = (t == nt - 2);
            const char* a1 = cA + (size_t)(t + 1) * kstep;
            const char* a2 = last ? nA : cA + (size_t)(t + 2) * kstep; const char* b2 = last ? nB : cB + (size_t)(t + 2) * kstep;
            const char* a3 = a2 + kstep; const char* b3 = b2 + kstep;
            if (last && has_next) S.a_ready(nxt);
            PG8_LDB(B0, 0, 0); PG8_SCHED; PG8_LDA(At, 0, 0); PG8_STAGE(PG8_SA(1, 1), a1 + hstep, voffA);
            PG8_WAIT_L(8); PG8_BAR; PG8_WAIT_L(0); PG8_MMA(0, 0, At, B0); PG8_BAR; PG8_SCHED;
            PG8_LDB(B1, 0, 1); PG8_STAGE(PG8_SB(0, 0), b2, voffB);
            PG8_BAR; PG8_WAIT_L(0); PG8_MMA(0, 1, At, B1); PG8_BAR;
            PG8_LDA(At, 0, 1); PG8_STAGE(PG8_SA(0, 0), a2, voffA);
            PG8_BAR; PG8_WAIT_L(0); PG8_MMA(1, 0, At, B0); PG8_BAR; PG8_SCHED;
            PG8_STAGE(PG8_SB(0, 1), b2 + hstep, voffB);
            PG8_WAIT_V(6); PG8_BAR; PG8_MMA(1, 1, At, B1); PG8_BAR;
            PG8_LDB(B0, 1, 0); PG8_SCHED; PG8_LDA(At, 1, 0); PG8_STAGE(PG8_SA(0, 1), a2 + hstep, voffA);
            PG8_WAIT_L(8); PG8_BAR; PG8_WAIT_L(0); PG8_MMA(0, 0, At, B0); PG8_BAR; PG8_SCHED;
            PG8_LDB(B1, 1, 1); PG8_STAGE(PG8_SB(1, 0), b3, voffB);
            PG8_BAR; PG8_WAIT_L(0); PG8_MMA(0, 1, At, B1); PG8_BAR;
            PG8_LDA(At, 1, 1); PG8_STAGE(PG8_SA(1, 0), a3, voffA);
            PG8_BAR; PG8_WAIT_L(0); PG8_MMA(1, 0, At, B0); PG8_BAR; PG8_SCHED;
            PG8_STAGE(PG8_SB(1, 1), b3 + hstep, voffB);
            PG8_WAIT_V(6); PG8_BAR; PG8_MMA(1, 1, At, B1); PG8_BAR;
        }
        PG8_STAMP();
        if constexpr (!Epi::AFTER_DRAIN) { E(acc, cur, wr, wc, fr, fq); S.done(cur); }
        PG8_STAMP();
        if (!has_next) break;
#pragma unroll
        for (int a = 0; a < 2; ++a)
#pragma unroll
            for (int b = 0; b < 2; ++b)
#pragma unroll
                for (int m = 0; m < 4; ++m)
#pragma unroll
                    for (int n = 0; n < 2; ++n) acc[a][b][m][n] = (f32x4){0.f, 0.f, 0.f, 0.f};
        cur = nxt; cA = nA; cB = nB; ++ui;
    }
    PG8_WAIT_V(0);
    if (wr == 0) PG8_BAR;
    PG8_BAR;
    if constexpr (Epi::AFTER_DRAIN) { E.fused(acc, cur, wr, wc, fr, fq, lds, wid, lane); S.done(cur); }
    PG8_STAMP();
    if (STAMP && wid == 0) { stamps[lane] = lane < nts ? (((unsigned long long)(unsigned)ts_hi << 32) | (unsigned)ts_lo) : 0ull;
        if (lane == 62) stamps[62] = rt_entry; if (lane == 63) stamps[63] = (unsigned long long)wall_clock64(); }
#undef PG8_STAMP
#undef PG8_SA
#undef PG8_SB
#undef PG8_STAGE
#undef PG8_LDA
#undef PG8_LDB
#undef PG8_MMA
#undef PG8_WAIT_V
#undef PG8_WAIT_L
#undef PG8_BAR
#undef PG8_SCHED
}
}
#define XB_TMO      128
#define XB_XCNT(j)  (256  + 64 * (j))
#define XB_XSUB(j)  (1280 + 64 * (j))
#define XB_XGEN(j)  (2304 + 64 * (j))
#define XB_TOP      3328
#define XB_TOPGEN   3392
#define XCD_BAR_WORDS 3456
#define XB_SPIN_CAP (1u << 18)

__device__ __forceinline__ unsigned xb_ld(unsigned* p)              { return __hip_atomic_load(p, __ATOMIC_RELAXED, __HIP_MEMORY_SCOPE_AGENT); }
__device__ __forceinline__ unsigned xb_add(unsigned* p, unsigned v) { return __hip_atomic_fetch_add(p, v, __ATOMIC_RELAXED, __HIP_MEMORY_SCOPE_AGENT); }
__device__ __forceinline__ unsigned xb_xcc_id() { return (unsigned)__builtin_amdgcn_s_getreg((3 << 11) | 20) & 0xFu; }
#define XB_SPIN(cond, bar) do { unsigned _sp = 0; while (cond) { __builtin_amdgcn_s_sleep(1); \
    if ((++_sp & 255u) == 0u) { if (xb_ld(&(bar)[XB_TMO])) break; if (_sp > XB_SPIN_CAP) { atomicAdd(&(bar)[XB_TMO], 1u); break; } } } } while (0)

struct XcdBarrier {
    unsigned* bar; unsigned x;
    volatile LAS unsigned* st;
};

__device__ __forceinline__ XcdBarrier xcd_barrier_post(unsigned* bar, volatile LAS unsigned* st) {
    XcdBarrier b; b.bar = bar; b.x = xb_xcc_id(); b.st = st;
    if (threadIdx.x == 0) (void)xb_add(&bar[XB_XCNT(b.x)], 1u);
    return b;
}
__device__ __forceinline__ void xcd_barrier_complete(unsigned* bar, unsigned x, unsigned& nloc, unsigned& nx) {
    const unsigned G = gridDim.x * gridDim.y * gridDim.z;
    unsigned sum, cnt, mine, sp = 0u;
    for (;;) {
        sum = 0u; cnt = 0u; mine = 0u;
#pragma unroll
        for (unsigned j = 0; j < 16; ++j) { const unsigned c = xb_ld(&bar[XB_XCNT(j)]); sum += c; cnt += (c > 0u) ? 1u : 0u; mine = (j == x) ? c : mine; }
        if (sum == G) break;
        __builtin_amdgcn_s_sleep(1);
        if ((++sp & 255u) == 0u) { if (xb_ld(&bar[XB_TMO])) break; if (sp > XB_SPIN_CAP) { atomicAdd(&bar[XB_TMO], 1u); break; } }
    }
    nloc = mine > 0u ? mine : 1u; nx = cnt > 0u ? cnt : 1u;
}

__device__ __forceinline__ void xcd_barrier(const XcdBarrier& b) {
    asm volatile("s_waitcnt vmcnt(0)" ::: "memory");
    __syncthreads();
    if (threadIdx.x == 0) {
        unsigned* bar = b.bar;
        __builtin_amdgcn_s_waitcnt(0);
        unsigned nloc = b.st[0], nx = b.st[1];
        if (nloc == 0u) { xcd_barrier_complete(bar, b.x, nloc, nx); b.st[0] = nloc; b.st[1] = nx; }
        const unsigned old = xb_add(&bar[XB_XSUB(b.x)], 1u);
        const unsigned gen = old / nloc;
        if (old + 1u == (gen + 1u) * nloc) {
            __builtin_amdgcn_fence(__ATOMIC_RELEASE, "agent");
            asm volatile("s_waitcnt vmcnt(0)" ::: "memory");
            const unsigned og = xb_add(&bar[XB_TOP], 1u);
            const unsigned tg = og / nx;
            if (og + 1u == (tg + 1u) * nx) xb_add(&bar[XB_TOPGEN], 1u);
            else XB_SPIN(xb_ld(&bar[XB_TOPGEN]) == tg, bar);
            __builtin_amdgcn_fence(__ATOMIC_ACQUIRE, "agent");
            xb_add(&bar[XB_XGEN(b.x)], 1u);
            asm volatile("s_waitcnt vmcnt(0)" ::: "memory");
        } else {
            XB_SPIN(xb_ld(&bar[XB_XGEN(b.x)]) == gen, bar);
            __builtin_amdgcn_fence(__ATOMIC_ACQUIRE, "agent");
            asm volatile("s_waitcnt vmcnt(0)" ::: "memory");
        }
    }
    __syncthreads();
}

using pg8::bf16_t; using pg8::bf16x8; using pg8::f32x4; using pg8::u32x4; using pg8::Unit;

typedef LAS unsigned char* ldsp;
typedef unsigned u32x2 __attribute__((ext_vector_type(2)));
typedef float f32x2v __attribute__((ext_vector_type(2)));

constexpr int D = 1024, NB = 8, SEQ = 4096, MTOT = NB * SEQ, DIN = 9216;
constexpr int MH = MTOT / 2;
constexpr float EPS = 1e-6f;
constexpr int C_HQ = 0, C_HF = 1024, C_HI = 2048, C_HZ = 3072, C_RQ = 4096, C_RK = 4608, C_RV = 5120, C_RZ = 6144, C_GA = 7168, C_GB = 8192;
constexpr int NSEG = 8, SEGLEN = 512, NCH = SEGLEN / 64;
constexpr size_t MiB = 1u << 20;
constexpr size_t WS_MOD = 0, WS_BAR = 106496, WS_LB = 131072, WS_ROPE = 262144, WS_WIN = 2 * MiB, WS_WOUT = 20 * MiB, WS_SLA = 22 * MiB, WS_SLB = 38 * MiB, WS_DA = 46 * MiB,
                 WS_H = 48 * MiB, WS_PROJ = 112 * MiB, WS_END = 400 * MiB;
constexpr int L_QT = 0, L_KT = 17408, L_KTT = 34816, L_VT = 53248, L_SM = 71680, L_AM = 106496, L_OF = 115712, L_SUB = 149504, L_EM = 153600, L_XB = 154624, LDS_BYTES = 154640;
constexpr int RS_D = 272, RS_S = 144, RS_O = 528;

__device__ __forceinline__ unsigned pkbf(float lo, float hi) { return pg8::cvt_pk_bf16(lo, hi); }
__device__ __forceinline__ float bflo(unsigned w) { return __uint_as_float(w << 16); }
__device__ __forceinline__ float bfhi(unsigned w) { return __uint_as_float(w & 0xffff0000u); }
__device__ __forceinline__ float ex2(float x) { return __builtin_amdgcn_exp2f(x); }
__device__ __forceinline__ float sigm(float x) { return __builtin_amdgcn_rcpf(1.0f + ex2(-1.4426950408889634f * x)); }
__device__ __forceinline__ float silu(float x) { return x * sigm(x); }

struct EpiProj {
    static constexpr bool PERM = true, AFTER_DRAIN = false;
    bf16_t* O; const float* lb; const float* rope;
    __device__ __forceinline__ void operator()(const f32x4 (&acc)[2][2][4][2], const Unit& u, int wr, int wc, int fr, int fq) const {
        const int pn = u.pn;
        const int mode = pn < 4 ? 1 : pn < 8 ? 2 : pn < 12 ? 0 : pn < 16 ? 1 : pn < 18 ? 3 : pn < 20 ? 4 : pn < 24 ? 0 : pn < 28 ? 1 : 5;
        const int row0 = u.pm * 256 + wr * 64 + fr;
        const int col0 = pn * 256 + wc * 32 + 8 * fq;
        f32x4 lbv[2][2];
#pragma unroll
        for (int bj = 0; bj < 2; ++bj)
#pragma unroll
            for (int n = 0; n < 2; ++n) lbv[bj][n] = (mode == 2) ? *(const f32x4*)(lb + (col0 - C_HF) + bj * 128 + 4 * n) : (f32x4){0.f, 0.f, 0.f, 0.f};
#pragma unroll
        for (int ai = 0; ai < 2; ++ai)
#pragma unroll
            for (int m = 0; m < 4; ++m) {
                const int row = row0 + ai * 128 + m * 16;
                bf16_t* rowp = O + (size_t)row * DIN + col0;
                f32x4 cs0 = (f32x4){1.f, 0.f, 1.f, 0.f}, cs1 = cs0;
                if (mode == 3 || mode == 4) { const float* rp = rope + ((size_t)(row & (SEQ - 1)) * 32 + ((col0 & 63) >> 1)) * 2; cs0 = *(const f32x4*)rp; cs1 = *(const f32x4*)(rp + 4); }
#pragma unroll
                for (int bj = 0; bj < 2; ++bj) {
                    f32x4 v0 = acc[ai][bj][m][0], v1 = acc[ai][bj][m][1];
                    if (mode == 1) {
#pragma unroll
                        for (int j = 0; j < 4; ++j) { v0[j] = silu(v0[j]); v1[j] = silu(v1[j]); }
                    } else if (mode == 5) {
#pragma unroll
                        for (int j = 0; j < 4; ++j) { v0[j] = sigm(v0[j]); v1[j] = sigm(v1[j]); }
                    } else if (mode == 2) {
#pragma unroll
                        for (int j = 0; j < 4; ++j) { const float l0 = lbv[bj][0][j], l1 = lbv[bj][1][j];
                            v0[j] = __builtin_amdgcn_logf(l0 + (1.0f - l0) * sigm(v0[j])); v1[j] = __builtin_amdgcn_logf(l1 + (1.0f - l1) * sigm(v1[j])); }
                    } else if (mode == 3 || mode == 4) {
                        const float sc = (mode == 4) ? 0.125f : 1.0f;
                        f32x4 r0, r1;
                        r0[0] = (v0[0] * cs0[0] - v0[1] * cs0[1]) * sc; r0[1] = (v0[0] * cs0[1] + v0[1] * cs0[0]) * sc;
                        r0[2] = (v0[2] * cs0[2] - v0[3] * cs0[3]) * sc; r0[3] = (v0[2] * cs0[3] + v0[3] * cs0[2]) * sc;
                        r1[0] = (v1[0] * cs1[0] - v1[1] * cs1[1]) * sc; r1[1] = (v1[0] * cs1[1] + v1[1] * cs1[0]) * sc;
                        r1[2] = (v1[2] * cs1[2] - v1[3] * cs1[3]) * sc; r1[3] = (v1[2] * cs1[3] + v1[3] * cs1[2]) * sc;
                        v0 = r0; v1 = r1;
                    }
                    u32x4 w; w.x = pkbf(v0[0], v0[1]); w.y = pkbf(v0[2], v0[3]); w.z = pkbf(v1[0], v1[1]); w.w = pkbf(v1[2], v1[3]);
                    *(u32x4*)(rowp + bj * 128) = w;
                }
            }
    }
};
struct EpiRes {
    static constexpr bool PERM = false, AFTER_DRAIN = false;
    const float* x; float* out; const float* mod;
    __device__ __forceinline__ void operator()(const f32x4 (&acc)[2][2][4][2], const Unit& u, int wr, int wc, int fr, int fq) const {
        const int row0 = u.pm * 256 + wr * 64 + fr, col0 = u.pn * 256 + wc * 32 + 4 * fq;
        const int b = (u.pm * 256) / SEQ;
        const float* gate = mod + (size_t)b * 3 * D + 2 * D + col0;
        f32x4 gv[2][2];
#pragma unroll
        for (int bj = 0; bj < 2; ++bj)
#pragma unroll
            for (int n = 0; n < 2; ++n) gv[bj][n] = *(const f32x4*)(gate + bj * 128 + n * 16);
#pragma unroll
        for (int ai = 0; ai < 2; ++ai)
#pragma unroll
            for (int m = 0; m < 4; ++m) { const size_t off = (size_t)(row0 + ai * 128 + m * 16) * D + col0;
#pragma unroll
                for (int bj = 0; bj < 2; ++bj)
#pragma unroll
                    for (int n = 0; n < 2; ++n) { const f32x4 xs = *(const f32x4*)(x + off + bj * 128 + n * 16); *(f32x4*)(out + off + bj * 128 + n * 16) = xs + gv[bj][n] * acc[ai][bj][m][n]; }
                asm volatile("" ::: "memory"); }
    }
};

struct Params { const float* x; const float* c; const float* norm_g; const float* w_ada; const float* b_ada; const float* w_in; const float* lb_logits; const float* hg_norm_g;
                const float* ret_norm_g; const float* w_out; const float* final_g; float* out; unsigned char* ws; };

__device__ __forceinline__ void p0_mod(ldsp lds, const Params& p, int job) {
    const int tid = threadIdx.x, cl = tid & 63, ks = tid >> 6, n = job * 64 + cl;
    LAS float* sc = (LAS float*)lds;
    LAS float* red = (LAS float*)(lds + 32768);
    for (int i = tid; i < NB * D; i += 512) sc[i] = silu(p.c[i]);
    __syncthreads();
    float a[NB];
#pragma unroll
    for (int b = 0; b < NB; ++b) a[b] = 0.f;
    for (int k = ks * 128; k < ks * 128 + 128; ++k) { const float w = p.w_ada[(size_t)k * (3 * D) + n];
#pragma unroll
        for (int b = 0; b < NB; ++b) a[b] += sc[b * D + k] * w; }
#pragma unroll
    for (int b = 0; b < NB; ++b) red[(ks * NB + b) * 64 + cl] = a[b];
    __syncthreads();
    { const int b = tid >> 6; float s = p.b_ada[n];
#pragma unroll
      for (int q = 0; q < 8; ++q) s += red[(q * NB + b) * 64 + cl];
      ((float*)(p.ws + WS_MOD))[(size_t)b * 3 * D + n] = s; }
    __syncthreads();
}
__device__ __forceinline__ void p0_transpose(ldsp lds, const float* W, int N, bf16_t* Wt, int kt, int nt, bool permute) {
    const int tid = threadIdx.x; LAS float* t = (LAS float*)lds;
    const int nn = tid & 63; int src = nn;
    if (permute) src = (nn & 1) ? (nn >> 1) + 32 : (nn >> 1);
#pragma unroll
    for (int i = 0; i < 8; ++i) { const int kk = i * 8 + (tid >> 6); t[kk * 65 + nn] = W[(size_t)(kt * 64 + kk) * N + nt * 64 + src]; }
    __syncthreads();
    { const int n2 = tid >> 3, k8 = (tid & 7) * 8; float v[8];
#pragma unroll
      for (int i = 0; i < 8; ++i) v[i] = t[(k8 + i) * 65 + n2];
      u32x4 w; w.x = pkbf(v[0], v[1]); w.y = pkbf(v[2], v[3]); w.z = pkbf(v[4], v[5]); w.w = pkbf(v[6], v[7]);
      *(u32x4*)(Wt + (size_t)(nt * 64 + n2) * D + kt * 64 + k8) = w; }
    __syncthreads();
}
__device__ __forceinline__ void sincos_d(double r, double& s, double& c) {
    const double r2 = r * r; double cs = 1.0, sn = 1.0;
    double tc = 1.0, ts = 1.0;
#pragma unroll
    for (int k = 1; k <= 13; ++k) { tc *= -r2 / (double)((2 * k - 1) * (2 * k)); ts *= -r2 / (double)((2 * k) * (2 * k + 1)); cs += tc; sn += ts; }
    c = cs; s = sn * r;
}
__device__ __forceinline__ void p0_tables(const Params& p) {
    const int gt = blockIdx.x * 512 + threadIdx.x, gs = gridDim.x * 512;
    float* lb = (float*)(p.ws + WS_LB); float* rope = (float*)(p.ws + WS_ROPE);
    for (int i = gt; i < D; i += gs) { const float l0 = p.lb_logits[i], l1 = p.lb_logits[D + i]; const float mx = fmaxf(l0, l1); const float e0 = __expf(l0 - mx), e1 = __expf(l1 - mx); lb[i] = e0 / (e0 + e1); }
    for (int i = gt; i < SEQ * 32; i += gs) { const int pos = i >> 5, j = i & 31;
        const float ex = (float)j * (1.0f / 31.0f);
        const float invf = 1.0f / (float)exp((double)ex * 9.210340371976184);
        const float ang = (float)pos * invf;
        const double a = (double)ang; const double n = rint(a * 0.15915494309189535); const double r = fma(-n, 6.283185307179586, a) - n * 2.4492935982947064e-16;
        double s, c; sincos_d(r, s, c);
        rope[2 * i] = (float)c; rope[2 * i + 1] = (float)s; }
}
__device__ __forceinline__ void p0_hnorm(const Params& p) {
    const int lane = threadIdx.x & 63, wave = threadIdx.x >> 6;
    const float* mod = (const float*)(p.ws + WS_MOD); bf16_t* H = (bf16_t*)(p.ws + WS_H);
    for (int row = blockIdx.x * 8 + wave; row < MTOT; row += gridDim.x * 8) {
        const float* xr = p.x + (size_t)row * D; const int b = row / SEQ;
        f32x4 v[4]; float ss = 0.f;
#pragma unroll
        for (int i = 0; i < 4; ++i) { v[i] = *(const f32x4*)(xr + i * 256 + lane * 4); ss += v[i][0] * v[i][0] + v[i][1] * v[i][1] + v[i][2] * v[i][2] + v[i][3] * v[i][3]; }
#pragma unroll
        for (int o = 1; o < 64; o <<= 1) ss += __shfl_xor(ss, o);
        const float rstd = rsqrtf(ss * (1.0f / D) + EPS);
#pragma unroll
        for (int i = 0; i < 4; ++i) { const int c0 = i * 256 + lane * 4;
            const f32x4 g = *(const f32x4*)(p.norm_g + c0), sh = *(const f32x4*)(mod + (size_t)b * 3 * D + c0), sc = *(const f32x4*)(mod + (size_t)b * 3 * D + D + c0);
            const f32x4 hv = v[i] * rstd * g * (sc + 1.0f) + sh;
            u32x2 w; w.x = pkbf(hv[0], hv[1]); w.y = pkbf(hv[2], hv[3]);
            *(u32x2*)(H + (size_t)row * D + c0) = w; }
    }
}
__device__ __forceinline__ void p4_final(const Params& p) {
    const int lane = threadIdx.x & 63, wave = threadIdx.x >> 6;
    for (int row = blockIdx.x * 8 + wave; row < MTOT; row += gridDim.x * 8) {
        float* xr = p.out + (size_t)row * D;
        f32x4 v[4]; float ss = 0.f;
#pragma unroll
        for (int i = 0; i < 4; ++i) { v[i] = *(const f32x4*)(xr + i * 256 + lane * 4); ss += v[i][0] * v[i][0] + v[i][1] * v[i][1] + v[i][2] * v[i][2] + v[i][3] * v[i][3]; }
#pragma unroll
        for (int o = 1; o < 64; o <<= 1) ss += __shfl_xor(ss, o);
        const float rstd = rsqrtf(ss * (1.0f / D) + EPS);
#pragma unroll
        for (int i = 0; i < 4; ++i) { const int c0 = i * 256 + lane * 4; const f32x4 g = *(const f32x4*)(p.final_g + c0); *(f32x4*)(xr + c0) = v[i] * rstd * g; }
    }
}

template <bool OUT>
__device__ __forceinline__ void prep_hg(const int tid, ldsp lds, const bf16_t* P, int h, float& gs0, float& gs1) {
    const int dp = tid & 63, sub = tid >> 6, d = 2 * dp;
    const unsigned voff = (unsigned)(((8 * sub) * DIN + h * 128 + d) * 2);
    unsigned qv[8], gv[8], vv[8];
#pragma unroll
    for (int i = 0; i < 8; ++i) { const char* rb = (const char*)P + (size_t)i * (DIN * 2);
        qv[i] = OUT ? *(const unsigned*)(rb + C_HQ * 2 + voff) : 0u; gv[i] = *(const unsigned*)(rb + C_HF * 2 + voff); vv[i] = *(const unsigned*)(rb + C_HI * 2 + voff); }
    float b0[8], b1[8]; float r0 = 0.f, r1 = 0.f;
#pragma unroll
    for (int i = 0; i < 8; ++i) { r0 += bflo(gv[i]); b0[i] = r0; r1 += bfhi(gv[i]); b1[i] = r1; }
    LAS float* SUB = (LAS float*)(lds + L_SUB);
    *(LAS f32x2v*)(SUB + sub * 128 + d) = (f32x2v){r0, r1};
    __syncthreads();
    float p0 = 0.f, p1 = 0.f, m0 = 0.f, m1 = 0.f, t0 = 0.f, t1 = 0.f;
#pragma unroll
    for (int s = 0; s < 8; ++s) { const f32x2v x = *(const LAS f32x2v*)(SUB + s * 128 + d);
        if (s < sub) { p0 += x.x; p1 += x.y; } if (s < 4) { m0 += x.x; m1 += x.y; } t0 += x.x; t1 += x.y; }
    if (sub == 0) { LAS float* EM = (LAS float*)(lds + L_EM); EM[d] = ex2(m0); EM[d + 1] = ex2(m1); EM[128 + d] = ex2(t0 - m0); EM[128 + d + 1] = ex2(t1 - m1); }
    gs0 += t0; gs1 += t1;
    unsigned kt0[4], kt1[4], vt0[4], vt1[4]; float kp0 = 0.f, kp1 = 0.f;
#pragma unroll
    for (int i = 0; i < 8; ++i) { const int t = 8 * sub + i;
        const float x0 = fminf(fmaxf(p0 + b0[i] - m0, -115.f), 115.f), x1 = fminf(fmaxf(p1 + b1[i] - m1, -115.f), 115.f);
        const float k0 = (1.0f - ex2(bflo(gv[i]))) * ex2(-x0), k1 = (1.0f - ex2(bfhi(gv[i]))) * ex2(-x1);
        if (OUT) { *(LAS unsigned*)(lds + L_QT + t * RS_D + d * 2) = pkbf(bflo(qv[i]) * ex2(x0), bfhi(qv[i]) * ex2(x1));
                   *(LAS unsigned*)(lds + L_KT + t * RS_D + d * 2) = pkbf(k0, k1); }
        if (i & 1) { kt0[i >> 1] = pkbf(kp0, k0); kt1[i >> 1] = pkbf(kp1, k1);
                     vt0[i >> 1] = (vv[i - 1] & 0xffffu) | (vv[i] << 16); vt1[i >> 1] = (vv[i - 1] >> 16) | (vv[i] & 0xffff0000u); }
        else { kp0 = k0; kp1 = k1; } }
    *(LAS u32x4*)(lds + L_KTT + d * RS_S + sub * 16) = (u32x4){kt0[0], kt0[1], kt0[2], kt0[3]};
    *(LAS u32x4*)(lds + L_KTT + (d + 1) * RS_S + sub * 16) = (u32x4){kt1[0], kt1[1], kt1[2], kt1[3]};
    *(LAS u32x4*)(lds + L_VT + d * RS_S + sub * 16) = (u32x4){vt0[0], vt0[1], vt0[2], vt0[3]};
    *(LAS u32x4*)(lds + L_VT + (d + 1) * RS_S + sub * 16) = (u32x4){vt1[0], vt1[1], vt1[2], vt1[3]};
}
template <bool OUT>
__device__ __forceinline__ void prep_rt(const int tid, ldsp lds, const bf16_t* P, int h, float lg) {
    { const int dp = tid & 31, sub = tid >> 5, d = 2 * dp;
      const unsigned voff = (unsigned)(((4 * sub) * DIN + h * 64 + d) * 2);
      unsigned qv[4], kv[4];
#pragma unroll
      for (int i = 0; i < 4; ++i) { const char* rb = (const char*)P + (size_t)i * (DIN * 2);
          qv[i] = OUT ? *(const unsigned*)(rb + C_RQ * 2 + voff) : 0u; kv[i] = *(const unsigned*)(rb + C_RK * 2 + voff); }
      unsigned kt0[2], kt1[2]; float kp0 = 0.f, kp1 = 0.f;
#pragma unroll
      for (int i = 0; i < 4; ++i) { const int t = 4 * sub + i; const float ek = ex2((float)(31 - t) * lg);
          const float k0 = bflo(kv[i]) * ek, k1 = bfhi(kv[i]) * ek;
          if (OUT) { const float eq = ex2((float)(t - 31) * lg);
                     *(LAS unsigned*)(lds + L_QT + t * RS_D + d * 2) = pkbf(bflo(qv[i]) * eq, bfhi(qv[i]) * eq);
                     *(LAS unsigned*)(lds + L_KT + t * RS_D + d * 2) = pkbf(k0, k1); }
          if (i & 1) { kt0[i >> 1] = pkbf(kp0, k0); kt1[i >> 1] = pkbf(kp1, k1); } else { kp0 = k0; kp1 = k1; } }
      *(LAS u32x2*)(lds + L_KTT + d * RS_S + sub * 8) = (u32x2){kt0[0], kt0[1]};
      *(LAS u32x2*)(lds + L_KTT + (d + 1) * RS_S + sub * 8) = (u32x2){kt1[0], kt1[1]}; }
    { const int ep = tid & 63, sub = tid >> 6, e = 2 * ep;
      const unsigned voff = (unsigned)(((8 * sub) * DIN + h * 128 + e) * 2);
      unsigned vv[8], vt0[4], vt1[4];
#pragma unroll
      for (int i = 0; i < 8; ++i) vv[i] = *(const unsigned*)((const char*)P + (size_t)i * (DIN * 2) + C_RV * 2 + voff);
#pragma unroll
      for (int i = 0; i < 4; ++i) { vt0[i] = (vv[2 * i] & 0xffffu) | (vv[2 * i + 1] << 16); vt1[i] = (vv[2 * i] >> 16) | (vv[2 * i + 1] & 0xffff0000u); }
      *(LAS u32x4*)(lds + L_VT + e * RS_S + sub * 16) = (u32x4){vt0[0], vt0[1], vt0[2], vt0[3]};
      *(LAS u32x4*)(lds + L_VT + (e + 1) * RS_S + sub * 16) = (u32x4){vt1[0], vt1[1], vt1[2], vt1[3]}; }
    if (tid < 64) { const float e32 = ex2(32.0f * lg); LAS float* EM = (LAS float*)(lds + L_EM); EM[tid] = e32; EM[128 + tid] = e32; }
}
template <int DK, bool OUT>
__device__ __forceinline__ void mix_core(const int tid, ldsp lds, f32x4 (&S)[DK == 128 ? 8 : 4]) {
    constexpr int NE = DK == 128 ? 8 : 4;
    const int w = __builtin_amdgcn_readfirstlane(tid >> 6), lane = tid & 63, l15 = lane & 15, quad = lane >> 4;
    const int db = DK == 128 ? w : (w & 3), eb0 = DK == 128 ? 0 : (w >> 2) * 4;
    __syncthreads();
    { const f32x4 em4 = *(const LAS f32x4*)(lds + L_EM + (db * 16 + quad * 4) * 4);
#pragma unroll
      for (int i = 0; i < NE; ++i) S[i] *= em4; }
    if (OUT) {
#pragma unroll
        for (int i = 0; i < NE; ++i) *(LAS u32x2*)(lds + L_SM + ((eb0 + i) * 16 + l15) * RS_D + (db * 16 + quad * 4) * 2) = (u32x2){pkbf(S[i][0], S[i][1]), pkbf(S[i][2], S[i][3])};
        const int tb = w & 3;
#pragma unroll
        for (int si = 0; si < 2; ++si) { const int sb = (w >> 2) * 2 + si; f32x4 a = (f32x4){0.f, 0.f, 0.f, 0.f};
            if (sb <= tb) {
#pragma unroll
                for (int ks = 0; ks < DK / 32; ++ks) { const bf16x8 af = *(const LAS bf16x8*)(lds + L_QT + (tb * 16 + l15) * RS_D + (ks * 32 + quad * 8) * 2);
                    const bf16x8 bf = *(const LAS bf16x8*)(lds + L_KT + (sb * 16 + l15) * RS_D + (ks * 32 + quad * 8) * 2);
                    a = __builtin_amdgcn_mfma_f32_16x16x32_bf16(af, bf, a, 0, 0, 0); }
            }
#pragma unroll
            for (int j = 0; j < 4; ++j) { const int t = tb * 16 + quad * 4 + j, s = sb * 16 + l15; const float v = (s <= t) ? a[j] : 0.f;
                *(LAS unsigned short*)(lds + L_AM + t * RS_S + s * 2) = (unsigned short)(pkbf(v, 0.f) & 0xffffu); }
        }
        __syncthreads();
        f32x4 o[4];
#pragma unroll
        for (int i = 0; i < 4; ++i) o[i] = (f32x4){0.f, 0.f, 0.f, 0.f};
        const int oe0 = (w >> 2) * 4;
#pragma unroll
        for (int ks = 0; ks < DK / 32; ++ks) { const bf16x8 af = *(const LAS bf16x8*)(lds + L_QT + (tb * 16 + l15) * RS_D + (ks * 32 + quad * 8) * 2);
#pragma unroll
            for (int i = 0; i < 4; ++i) { const bf16x8 bf = *(const LAS bf16x8*)(lds + L_SM + ((oe0 + i) * 16 + l15) * RS_D + (ks * 32 + quad * 8) * 2);
                o[i] = __builtin_amdgcn_mfma_f32_16x16x32_bf16(af, bf, o[i], 0, 0, 0); }
            __builtin_amdgcn_sched_barrier(0); }
#pragma unroll
        for (int ks = 0; ks < 2; ++ks) { const bf16x8 af = *(const LAS bf16x8*)(lds + L_AM + (tb * 16 + l15) * RS_S + (ks * 32 + quad * 8) * 2);
#pragma unroll
            for (int i = 0; i < 4; ++i) { const bf16x8 bf = *(const LAS bf16x8*)(lds + L_VT + ((oe0 + i) * 16 + l15) * RS_S + (ks * 32 + quad * 8) * 2);
                o[i] = __builtin_amdgcn_mfma_f32_16x16x32_bf16(af, bf, o[i], 0, 0, 0); }
            __builtin_amdgcn_sched_barrier(0); }
#pragma unroll
        for (int i = 0; i < 4; ++i)
#pragma unroll
            for (int j = 0; j < 4; ++j) *(LAS float*)(lds + L_OF + (tb * 16 + quad * 4 + j) * RS_O + ((oe0 + i) * 16 + l15) * 4) = o[i][j];
    }
#pragma unroll
    for (int ks = 0; ks < 2; ++ks) { const bf16x8 af = *(const LAS bf16x8*)(lds + L_KTT + (db * 16 + l15) * RS_S + (ks * 32 + quad * 8) * 2);
#pragma unroll
        for (int i = 0; i < NE; ++i) { const bf16x8 bf = *(const LAS bf16x8*)(lds + L_VT + ((eb0 + i) * 16 + l15) * RS_S + (ks * 32 + quad * 8) * 2);
            S[i] = __builtin_amdgcn_mfma_f32_16x16x32_bf16(af, bf, S[i], 0, 0, 0); }
        __builtin_amdgcn_sched_barrier(0); }
    { const f32x4 ed4 = *(const LAS f32x4*)(lds + L_EM + (128 + db * 16 + quad * 4) * 4);
#pragma unroll
      for (int i = 0; i < NE; ++i) S[i] *= ed4; }
    __syncthreads();
}
__device__ __forceinline__ void epi_mix(const int tid, ldsp lds, const bf16_t* Prow, int zcol, int gcol, const float* gn, float (&am)[16], bool first) {
    const int t = tid >> 3, c = tid & 7;
    f32x4 o[4]; float ss = 0.f;
#pragma unroll
    for (int i = 0; i < 4; ++i) { o[i] = *(const LAS f32x4*)(lds + L_OF + t * RS_O + c * 64 + i * 16); ss += o[i][0] * o[i][0] + o[i][1] * o[i][1] + o[i][2] * o[i][2] + o[i][3] * o[i][3]; }
    ss += __shfl_xor(ss, 1); ss += __shfl_xor(ss, 2); ss += __shfl_xor(ss, 4);
    const float rstd = rsqrtf(ss * (1.0f / 128.0f) + EPS);
    const unsigned voff = (unsigned)((t * DIN + 16 * c) * 2);
    const u32x4 z0 = *(const u32x4*)((const char*)Prow + zcol * 2 + voff), z1 = *(const u32x4*)((const char*)Prow + zcol * 2 + 16 + voff);
    const u32x4 g0 = *(const u32x4*)((const char*)Prow + gcol * 2 + voff), g1 = *(const u32x4*)((const char*)Prow + gcol * 2 + 16 + voff);
#pragma unroll
    for (int i = 0; i < 4; ++i) { const f32x4 gg = *(const f32x4*)(gn + 16 * c + 4 * i);
        const unsigned zw0 = i < 2 ? z0[2 * i] : z1[2 * i - 4], zw1 = i < 2 ? z0[2 * i + 1] : z1[2 * i - 3];
        const unsigned gw0 = i < 2 ? g0[2 * i] : g1[2 * i - 4], gw1 = i < 2 ? g0[2 * i + 1] : g1[2 * i - 3];
        const float v0 = o[i][0] * rstd * gg[0] * bflo(zw0) * bflo(gw0), v1 = o[i][1] * rstd * gg[1] * bfhi(zw0) * bfhi(gw0);
        const float v2 = o[i][2] * rstd * gg[2] * bflo(zw1) * bflo(gw1), v3 = o[i][3] * rstd * gg[3] * bfhi(zw1) * bfhi(gw1);
        if (first) { am[4 * i] = v0; am[4 * i + 1] = v1; am[4 * i + 2] = v2; am[4 * i + 3] = v3; }
        else { am[4 * i] += v0; am[4 * i + 1] += v1; am[4 * i + 2] += v2; am[4 * i + 3] += v3; } }
}

__device__ __forceinline__ void p2a(ldsp lds, const Params& p) {
    const bf16_t* proj = (const bf16_t*)(p.ws + WS_PROJ);
    int tid_ = threadIdx.x; asm volatile("" : "+v"(tid_)); const int tid = tid_;
    for (int u = blockIdx.x; u < 256; u += gridDim.x) {
        const int seg = u & 7, h = (u >> 3) & 7, bl = u >> 6;
        if (seg == NSEG - 1) continue;
        const float lg = log1pf(-exp2f(-5.0f - (float)h)) * 1.4426950408889634f;
        f32x4 SA[8], SB[4];
#pragma unroll
        for (int i = 0; i < 8; ++i) SA[i] = (f32x4){0.f, 0.f, 0.f, 0.f};
#pragma unroll
        for (int i = 0; i < 4; ++i) SB[i] = (f32x4){0.f, 0.f, 0.f, 0.f};
        float gs0 = 0.f, gs1 = 0.f;
        const size_t row0 = (size_t)bl * SEQ + (size_t)seg * SEGLEN;
        for (int c = 0; c < NCH; ++c) { const bf16_t* P = proj + (row0 + (size_t)c * 64) * DIN;
            prep_hg<false>(tid, lds, P, h, gs0, gs1); mix_core<128, false>(tid, lds, SA);
            prep_rt<false>(tid, lds, P, h, lg);       mix_core<64, false>(tid, lds, SB); }
        float* sla = (float*)(p.ws + WS_SLA) + (size_t)u * 16384; float* slb = (float*)(p.ws + WS_SLB) + (size_t)u * 8192; float* da = (float*)(p.ws + WS_DA) + (size_t)u * 128;
#pragma unroll
        for (int i = 0; i < 8; ++i) *(f32x4*)((char*)sla + (unsigned)(tid * 128 + i * 16)) = SA[i];
#pragma unroll
        for (int i = 0; i < 4; ++i) *(f32x4*)((char*)slb + (unsigned)(tid * 64 + i * 16)) = SB[i];
        if (tid < 64) { da[2 * tid] = ex2(gs0); da[2 * tid + 1] = ex2(gs1); }
    }
}
__device__ __forceinline__ void p2b(ldsp lds, const Params& p, int half) {
    const bf16_t* proj = (const bf16_t*)(p.ws + WS_PROJ);
    bf16_t* Mo = (bf16_t*)(p.ws + WS_H) + (size_t)half * MH * D;
    int tid_ = threadIdx.x; asm volatile("" : "+v"(tid_)); const int tid = tid_, w = __builtin_amdgcn_readfirstlane(tid >> 6), lane = tid & 63, quad = lane >> 4;
    for (int u = blockIdx.x; u < 256; u += gridDim.x) {
        const int seg = u & 7, h = (u >> 3) & 7, bl = u >> 6;
        const float lg = log1pf(-exp2f(-5.0f - (float)h)) * 1.4426950408889634f;
        const float dB = ex2((float)SEGLEN * lg);
        f32x4 SA[8], SB[4];
#pragma unroll
        for (int i = 0; i < 8; ++i) SA[i] = (f32x4){0.f, 0.f, 0.f, 0.f};
#pragma unroll
        for (int i = 0; i < 4; ++i) SB[i] = (f32x4){0.f, 0.f, 0.f, 0.f};
        for (int s = 0; s < seg; ++s) { const int uu = u - seg + s;
            const float* sla = (const float*)(p.ws + WS_SLA) + (size_t)uu * 16384; const float* slb = (const float*)(p.ws + WS_SLB) + (size_t)uu * 8192;
            const f32x4 d4 = *(const f32x4*)((const float*)(p.ws + WS_DA) + (size_t)uu * 128 + w * 16 + quad * 4);
#pragma unroll
            for (int i = 0; i < 8; ++i) SA[i] = SA[i] * d4 + *(const f32x4*)((const char*)sla + (unsigned)(tid * 128 + i * 16));
#pragma unroll
            for (int i = 0; i < 4; ++i) SB[i] = SB[i] * dB + *(const f32x4*)((const char*)slb + (unsigned)(tid * 64 + i * 16)); }
        float gs0 = 0.f, gs1 = 0.f;
        const size_t row0 = (size_t)bl * SEQ + (size_t)seg * SEGLEN;
        const int t = tid >> 3, c8 = tid & 7;
        for (int c = 0; c < NCH; ++c) { const bf16_t* P = proj + (row0 + (size_t)c * 64) * DIN;
            float am[16];
            prep_hg<true>(tid, lds, P, h, gs0, gs1); mix_core<128, true>(tid, lds, SA);
            epi_mix(tid, lds, P + h * 128, C_HZ, C_GA, p.hg_norm_g + h * 128, am, true);
            prep_rt<true>(tid, lds, P, h, lg);       mix_core<64, true>(tid, lds, SB);
            epi_mix(tid, lds, P + h * 128, C_RZ, C_GB, p.ret_norm_g + h * 128, am, false);
            bf16_t* mo = Mo + (row0 + (size_t)c * 64 + t) * D + h * 128 + 16 * c8;
            *(u32x4*)mo = (u32x4){pkbf(am[0], am[1]), pkbf(am[2], am[3]), pkbf(am[4], am[5]), pkbf(am[6], am[7])};
            *(u32x4*)(mo + 8) = (u32x4){pkbf(am[8], am[9]), pkbf(am[10], am[11]), pkbf(am[12], am[13]), pkbf(am[14], am[15])};
        }
    }
}

#ifndef REP_P0A
#define REP_P0A 1
#endif
#ifndef REP_P0B
#define REP_P0B 1
#endif
#ifndef REP_P3
#define REP_P3 1
#endif
#ifndef REP_P1
#define REP_P1 1
#endif
#ifndef REP_P2A
#define REP_P2A 1
#endif
#ifndef REP_P2B
#define REP_P2B 1
#endif
__global__ void __launch_bounds__(512, 2) fwd_megakernel(Params p) {
    extern __shared__ __attribute__((aligned(16))) unsigned char lds_raw[];
    ldsp lds = (ldsp)lds_raw;
    cg::grid_group grid = cg::this_grid();
    const int G = gridDim.x;
    if (threadIdx.x == 0) *(LAS u32x4*)(lds + L_XB) = (u32x4){0u, 0u, 0u, 0u};
    __syncthreads();
    const XcdBarrier xbar = xcd_barrier_post((unsigned*)(p.ws + WS_BAR), (volatile LAS unsigned*)(lds + L_XB));
#define GSYNC() xcd_barrier(xbar)
    for (int r_ = 0; r_ < REP_P0A; ++r_) {
    for (int j = blockIdx.x; j < 48; j += G) p0_mod(lds, p, j);
    p0_tables(p);
    for (int tI = blockIdx.x; tI < 144 * 16 + 16 * 16; tI += G) {
        if (tI < 144 * 16) { const int nt = tI / 16, kt = tI % 16; p0_transpose(lds, p.w_in, DIN, (bf16_t*)(p.ws + WS_WIN), kt, nt, nt >= C_RQ / 64 && nt < C_RV / 64); }
        else { const int q = tI - 144 * 16; p0_transpose(lds, p.w_out, D, (bf16_t*)(p.ws + WS_WOUT), q % 16, q / 16, false); }
    }
    grid.sync(); }
    for (int r_ = 0; r_ < REP_P0B; ++r_) p0_hnorm(p);
    GSYNC();
    for (int half = 0; half < 2; ++half) {
        for (int r_ = 0; r_ < REP_P1; ++r_) { pg8::Gemm g{(const bf16_t*)(p.ws + WS_H) + (size_t)half * MH * D, (const bf16_t*)(p.ws + WS_WIN), MH, DIN, D};
          pg8::StaticOrder S; S.init(MH, DIN, G, (int)blockIdx.x);
          EpiProj E{(bf16_t*)(p.ws + WS_PROJ), (const float*)(p.ws + WS_LB), (const float*)(p.ws + WS_ROPE)};
          pg8::gemm_phase<EpiProj, pg8::StaticOrder, false>(lds, g, S, E, nullptr); if (r_ + 1 < REP_P1) GSYNC(); }
        GSYNC();
        for (int r_ = 0; r_ < REP_P2A; ++r_) { p2a(lds, p); if (r_ + 1 < REP_P2A) GSYNC(); }
        GSYNC();
        for (int r_ = 0; r_ < REP_P2B; ++r_) { p2b(lds, p, half); if (r_ + 1 < REP_P2B) GSYNC(); }
        GSYNC();
    }
    for (int r_ = 0; r_ < REP_P3; ++r_) { pg8::Gemm g{(const bf16_t*)(p.ws + WS_H), (const bf16_t*)(p.ws + WS_WOUT), MTOT, D, D};
      pg8::StaticOrder S; S.init(MTOT, D, G, (int)blockIdx.x);
      EpiRes E{p.x, p.out, (const float*)(p.ws + WS_MOD)};
      pg8::gemm_phase<EpiRes, pg8::StaticOrder, false>(lds, g, S, E, nullptr); if (r_ + 1 < REP_P3) GSYNC(); }
    GSYNC();
    p4_final(p);
}

extern "C" void kernel_launch(void* const* d_in, const int* in_sizes, int n_in, void* d_out, int out_size, void* d_ws, size_t ws_size, hipStream_t stream) {
    static int grid = 0;
    if (grid == 0) {
        if (n_in != 11 || out_size != MTOT * D || ws_size < WS_END) { fprintf(stderr, "kernel_launch: unexpected shapes (n_in %d out %d ws %zu)\n", n_in, out_size, ws_size); grid = -1; return; }
        int dev = 0, cus = 0, per_cu = 0;
        hipGetDevice(&dev); hipDeviceGetAttribute(&cus, hipDeviceAttributeMultiprocessorCount, dev);
        if (hipFuncSetAttribute((const void*)fwd_megakernel, hipFuncAttributeMaxDynamicSharedMemorySize, LDS_BYTES) != hipSuccess) { fprintf(stderr, "kernel_launch: hipFuncSetAttribute failed\n"); grid = -1; return; }
        if (hipOccupancyMaxActiveBlocksPerMultiprocessor(&per_cu, (const void*)fwd_megakernel, 512, LDS_BYTES) != hipSuccess || per_cu < 1) { fprintf(stderr, "kernel_launch: occupancy query failed (%d)\n", per_cu); per_cu = 1; }
        (void)hipGetLastError();
        grid = cus;
        fprintf(stderr, "kernel_launch: cus %d per_cu %d grid %d\n", cus, per_cu, grid);
    }
    if (grid < 0) return;
    Params p{};
    p.x = (const float*)d_in[0]; p.c = (const float*)d_in[1]; p.norm_g = (const float*)d_in[2]; p.w_ada = (const float*)d_in[3]; p.b_ada = (const float*)d_in[4];
    p.w_in = (const float*)d_in[5]; p.lb_logits = (const float*)d_in[6]; p.hg_norm_g = (const float*)d_in[7]; p.ret_norm_g = (const float*)d_in[8]; p.w_out = (const float*)d_in[9];
    p.final_g = (const float*)d_in[10]; p.out = (float*)d_out; p.ws = (unsigned char*)d_ws;
    if (hipMemsetAsync((char*)d_ws + WS_BAR, 0, XCD_BAR_WORDS * 4, stream) != hipSuccess) { fprintf(stderr, "kernel_launch: memset failed\n"); return; }
    void* args[] = {&p};
    hipError_t e = hipLaunchCooperativeKernel((const void*)fwd_megakernel, dim3(grid), dim3(512), args, LDS_BYTES, stream);
    if (e != hipSuccess) fprintf(stderr, "kernel_launch: cooperative launch failed: %s (grid %d)\n", hipGetErrorString(e), grid);
}
```

```cpp
#include <hip/hip_runtime.h>
#include <hip/hip_cooperative_groups.h>
#include <cstdio>
namespace cg = cooperative_groups;
#define LAS __attribute__((address_space(3)))
namespace pg8 {
#define PG8_LAS __attribute__((address_space(3)))
typedef unsigned short bf16_t;
typedef short bf16x8 __attribute__((ext_vector_type(8)));
typedef float f32x4 __attribute__((ext_vector_type(4)));
typedef unsigned u32x4 __attribute__((ext_vector_type(4)));
constexpr int BM = 256, BK = 64, HALF = 128, HTB = HALF * BK * 2  , STAGE_BYTES = 8 * HTB, NXCD = 8, WGM = 8;

__host__ __device__ __forceinline__ int lds_byte(int r, int c) { const int st = (r >> 4) * 2 + (c >> 5), rr = r & 15, cc = c & 31, ob = rr * 64 + cc * 2; return st * 1024 + (ob ^ (((ob >> 9) & 1) << 5)); }
__host__ __device__ __forceinline__ void stage_rc(int b, int& R, int& C) { const int st = b / 1024, sb = b % 1024, swz = sb ^ (((sb >> 9) & 1) << 5); R = (st >> 1) * 16 + swz / 64; C = (st & 1) * 32 + (swz % 64) / 2; }
__host__ __device__ __forceinline__ int perm32(int rho) { const int n = rho >> 4, i = rho & 15; return 8 * (i >> 2) + 4 * n + (i & 3); }

struct Unit { int pm, pn; };
struct Gemm { const bf16_t* A; const bf16_t* Bt; int M, N, K; };
struct StaticOrder {
    int nM, nN, nwg, G, c;
    __host__ __device__ void init(int M, int N, int G_, int c_) { nM = M / BM; nN = N / BM; nwg = nM * nN; G = G_; c = c_; }
    __host__ __device__ bool next(int i, Unit& u) const {
        const long L = (long)i * G + c; if (L >= nwg) return false;
        int wgid = (int)L; { const int q = nwg / NXCD, r = nwg % NXCD, xcd = wgid % NXCD, off = wgid / NXCD; wgid = (xcd < r ? xcd * (q + 1) : r * (q + 1) + (xcd - r) * q) + off; }
        const int nig = WGM * nN, gid = wgid / nig, fm = gid * WGM, gsz = (nM - fm) < WGM ? (nM - fm) : WGM;
        u.pm = fm + ((wgid % nig) % gsz); u.pn = (wgid % nig) / gsz; return true;
    }
    __device__ __forceinline__ void a_ready(const Unit&) const {}
    __device__ __forceinline__ void done(const Unit&) const {}
};
__device__ __forceinline__ unsigned cvt_pk_bf16(float lo, float hi) { unsigned r; asm volatile("v_cvt_pk_bf16_f32 %0, %1, %2" : "=v"(r) : "v"(lo), "v"(hi)); return r; }
typedef float f32x2 __attribute__((ext_vector_type(2)));
template <class Epi, class Sched, bool STAMP = false>
__device__ __forceinline__ void gemm_phase(PG8_LAS unsigned char* lds, const Gemm g, const Sched& S, const Epi& E, unsigned long long* stamps) {
    int tid_ = threadIdx.x; asm volatile("" : "+v"(tid_)); const int tid = tid_, wid = __builtin_amdgcn_readfirstlane(tid >> 6), lane = tid & 63, wr = wid >> 2, wc = wid & 3, fr = lane & 15, fq = lane >> 4;
    const int K = g.K, nt = K / BK;
    int ts_lo = 0, ts_hi = 0, nts = 0; const unsigned long long rt_entry = STAMP ? (unsigned long long)wall_clock64() : 0ull;
#define PG8_STAMP() do { if (STAMP && wid == 0 && nts < 64) { const unsigned long long _c = (unsigned long long)clock64(); \
        ts_lo = (lane == nts) ? (int)(unsigned)_c : ts_lo; ts_hi = (lane == nts) ? (int)(unsigned)(_c >> 32) : ts_hi; ++nts; } } while (0)
    PG8_STAMP();
    unsigned voffA[2], voffB[2];
#pragma unroll
    for (int i = 0; i < 2; ++i) { int R, C; stage_rc(tid * 16 + i * 8192, R, C); const int Rb = Epi::PERM ? ((R & ~31) + perm32(R & 31)) : R;
        voffA[i] = (unsigned)(R * K + C) * 2u; voffB[i] = (unsigned)(Rb * K + C) * 2u; }
    const size_t kstep = (size_t)(BK * 2);
    const size_t hstep = (size_t)HALF * K * 2;
    const size_t tstep = 2 * hstep;
    const unsigned ldsw = (unsigned)wid * 1024u;
    const int aoff = lds_byte(wr * 64 + fr, fq * 8), boff = lds_byte(wc * 32 + fr, fq * 8);
#define PG8_SA(b, h) (((b) * 2 + (h)) * HTB)
#define PG8_SB(b, h) ((4 + (b) * 2 + (h)) * HTB)
#define PG8_STAGE(bufoff, gbase, voff) do { _Pragma("unroll") for (int _i = 0; _i < 2; ++_i) \
        __builtin_amdgcn_global_load_lds((const unsigned*)((const char*)(gbase) + (voff)[_i]), (PG8_LAS unsigned*)(lds + (bufoff) + ldsw + _i * 8192), 16, 0, 0); } while (0)
#define PG8_LDA(dst, b, h) do { _Pragma("unroll") for (int m = 0; m < 4; ++m) _Pragma("unroll") for (int k = 0; k < 2; ++k) dst[m][k] = *(const PG8_LAS bf16x8*)(lds + PG8_SA(b, h) + aoff + m * 2048 + k * 1024); } while (0)
#define PG8_LDB(dst, b, h) do { _Pragma("unroll") for (int n = 0; n < 2; ++n) _Pragma("unroll") for (int k = 0; k < 2; ++k) dst[n][k] = *(const PG8_LAS bf16x8*)(lds + PG8_SB(b, h) + boff + n * 2048 + k * 1024); } while (0)
#define PG8_MMA(ai, bj, At, Bt) do { __builtin_amdgcn_s_setprio(1); _Pragma("unroll") for (int m = 0; m < 4; ++m) _Pragma("unroll") for (int n = 0; n < 2; ++n) _Pragma("unroll") for (int k = 0; k < 2; ++k) \
        acc[ai][bj][m][n] = __builtin_amdgcn_mfma_f32_16x16x32_bf16(Bt[n][k], At[m][k], acc[ai][bj][m][n], 0, 0, 0); __builtin_amdgcn_s_setprio(0); } while (0)
#define PG8_WAIT_V(n) asm volatile("s_waitcnt vmcnt(" #n ")" ::: "memory")
#define PG8_WAIT_L(n) asm volatile("s_waitcnt lgkmcnt(" #n ")" ::: "memory")
#define PG8_BAR __builtin_amdgcn_s_barrier()
#define PG8_SCHED __builtin_amdgcn_sched_barrier(0)
    Unit cur, nxt; int ui = 0;
    if (!S.next(0, cur)) return;
    f32x4 acc[2][2][4][2];
#pragma unroll
    for (int a = 0; a < 2; ++a)
#pragma unroll
        for (int b = 0; b < 2; ++b)
#pragma unroll
            for (int m = 0; m < 4; ++m)
#pragma unroll
                for (int n = 0; n < 2; ++n) acc[a][b][m][n] = (f32x4){0.f, 0.f, 0.f, 0.f};
    bf16x8 At[4][2], B0[2][2], B1[2][2];
    const char* cA = (const char*)g.A + (size_t)cur.pm * tstep; const char* cB = (const char*)g.Bt + (size_t)cur.pn * tstep;
    S.a_ready(cur);
    PG8_STAGE(PG8_SB(0, 0), cB, voffB); PG8_STAGE(PG8_SA(0, 0), cA, voffA); PG8_STAGE(PG8_SB(0, 1), cB + hstep, voffB); PG8_STAGE(PG8_SA(0, 1), cA + hstep, voffA);
    if (wr == 1) PG8_BAR;
    PG8_WAIT_V(4); PG8_BAR;
    PG8_STAGE(PG8_SB(1, 0), cB + kstep, voffB); PG8_STAGE(PG8_SA(1, 0), cA + kstep, voffA); PG8_STAGE(PG8_SB(1, 1), cB + hstep + kstep, voffB);
    PG8_WAIT_V(6); PG8_BAR;
    PG8_STAMP();
    for (;;) {
        const bool has_next = S.next(ui + 1, nxt);
        const char* nA = has_next ? (const char*)g.A + (size_t)nxt.pm * tstep : cA; const char* nB = has_next ? (const char*)g.Bt + (size_t)nxt.pn * tstep : cB;
        for (int t = 0; t < nt; t += 2) {
            const bool last = (t == nt - 2);
            const char* a1 = cA + (size_t)(t + 1) * kstep;
            const char* a2 = last ? nA : cA + (size_t)(t + 2) * kstep; const char* b2 = last ? nB : cB + (size_t)(t + 2) * kstep;
            const char* a3 = a2 + kstep; const char* b3 = b2 + kstep;
            if (last && has_next) S.a_ready(nxt);
            PG8_LDB(B0, 0, 0); PG8_SCHED; PG8_LDA(At, 0, 0); PG8_STAGE(PG8_SA(1, 1), a1 + hstep, voffA);
            PG8_WAIT_L(8); PG8_BAR; PG8_WAIT_L(0); PG8_MMA(0, 0, At, B0); PG8_BAR; PG8_SCHED;
            PG8_LDB(B1, 0, 1); PG8_STAGE(PG8_SB(0, 0), b2, voffB);
            PG8_BAR; PG8_WAIT_L(0); PG8_MMA(0, 1, At, B1); PG8_BAR;
            PG8_LDA(At, 0, 1); PG8_STAGE(PG8_SA(0, 0), a2, voffA);
            PG8_BAR; PG8_WAIT_L(0); PG8_MMA(1, 0, At, B0); PG8_BAR; PG8_SCHED;
            PG8_STAGE(PG8_SB(0, 1), b2 + hstep, voffB);
            PG8_WAIT_V(6); PG8_BAR; PG8_MMA(1, 1, At, B1); PG8_BAR;
            PG8_LDB(B0, 1, 0); PG8_SCHED; PG8_LDA(At, 1, 0); PG8_STAGE(PG8_SA(0, 1), a2 + hstep, voffA);
            PG8_WAIT_L(8); PG8_BAR; PG8_WAIT_L(0); PG8_MMA(0, 0, At, B0); PG8_BAR; PG8_SCHED;
            PG8_LDB(B1, 1, 1); PG8_STAGE(PG8_SB(1, 0), b3, voffB);
            PG8_BAR; PG8_WAIT_L(0); PG8_MMA(0, 1, At, B1); PG8_BAR;
            PG8_LDA(At, 1, 1); PG8_STAGE(PG8_SA(1, 0), a3, voffA);
            PG8_BAR; PG8_WAIT_L(0); PG8_MMA(1, 0, At, B0); PG8_BAR; PG8_SCHED;
            PG8_STAGE(PG8_SB(1, 1), b3 + hstep, voffB);
            PG8_WAIT_V(6); PG8_BAR; PG8_MMA(1, 1, At, B1); PG8_BAR;
        }
        PG8_STAMP();
        if constexpr (!Epi::AFTER_DRAIN) { E(acc, cur, wr, wc, fr, fq); S.done(cur); }
        PG8_STAMP();
        if (!has_next) break;
#pragma unroll
        for (int a = 0; a < 2; ++a)
#pragma unroll
            for (int b = 0; b < 2; ++b)
#pragma unroll
                for (int m = 0; m < 4; ++m)
#pragma unroll
                    for (int n = 0; n < 2; ++n) acc[a][b][m][n] = (f32x4){0.f, 0.f, 0.f, 0.f};
        cur = nxt; cA = nA; cB = nB; ++ui;
    }
    PG8_WAIT_V(0);
    if (wr == 0) PG8_BAR;
    PG8_BAR;
    if constexpr (Epi::AFTER_DRAIN) { E.fused(acc, cur, wr, wc, fr, fq, lds, wid, lane); S.done(cur); }
    PG8_STAMP();
    if (STAMP && wid == 0) { stamps[lane] = lane < nts ? (((unsigned long long)(unsigned)ts_hi << 32) | (unsigned)ts_lo) : 0ull;
        if (lane == 62) stamps[62] = rt_entry; if (lane == 63) stamps[63] = (unsigned long long)wall_clock64(); }
#undef PG8_STAMP
#undef PG8_SA
#undef PG8_SB
#undef PG8_STAGE
#undef PG8_LDA
#undef PG8_LDB
#undef PG8_MMA
#undef PG8_WAIT_V
#undef PG8_WAIT_L
#undef PG8_BAR
#undef PG8_SCHED
}
}
#define XB_TMO      128
#define XB_XCNT(j)  (256  + 64 * (j))
#define XB_XSUB(j)  (1280 + 64 * (j))
#define XB_XGEN(j)  (2304 + 64 * (j))
#define XB_TOP      3328
#define XB_TOPGEN   3392
#define XCD_BAR_WORDS 3456
#define XB_SPIN_CAP (1u << 18)

__device__ __forceinline__ unsigned xb_ld(unsigned* p)              { return __hip_atomic_load(p, __ATOMIC_RELAXED, __HIP_MEMORY_SCOPE_AGENT); }
__device__ __forceinline__ unsigned xb_add(unsigned* p, unsigned v) { return __hip_atomic_fetch_add(p, v, __ATOMIC_RELAXED, __HIP_MEMORY_SCOPE_AGENT); }
__device__ __forceinline__ unsigned xb_xcc_id() { return (unsigned)__builtin_amdgcn_s_getreg((3 << 11) | 20) & 0xFu; }
#define XB_SPIN(cond, bar) do { unsigned _sp = 0; while (cond) { __builtin_amdgcn_s_sleep(1); \
    if ((++_sp & 255u) == 0u) { if (xb_ld(&(bar)[XB_TMO])) break; if (_sp > XB_SPIN_CAP) { atomicAdd(&(bar)[XB_TMO], 1u); break; } } } } while (0)

struct XcdBarrier {
    unsigned* bar; unsigned x;
    volatile LAS unsigned* st;
};

__device__ __forceinline__ XcdBarrier xcd_barrier_post(unsigned* bar, volatile LAS unsigned* st) {
    XcdBarrier b; b.bar = bar; b.x = xb_xcc_id(); b.st = st;
    if (threadIdx.x == 0) (void)xb_add(&bar[XB_XCNT(b.x)], 1u);
    return b;
}
__device__ __forceinline__ void xcd_barrier_complete(unsigned* bar, unsigned x, unsigned& nloc, unsigned& nx) {
    const unsigned G = gridDim.x * gridDim.y * gridDim.z;
    unsigned sum, cnt, mine, sp = 0u;
    for (;;) {
        sum = 0u; cnt = 0u; mine = 0u;
#pragma unroll
        for (unsigned j = 0; j < 16; ++j) { const unsigned c = xb_ld(&bar[XB_XCNT(j)]); sum += c; cnt += (c > 0u) ? 1u : 0u; mine = (j == x) ? c : mine; }
        if (sum == G) break;
        __builtin_amdgcn_s_sleep(1);
        if ((++sp & 255u) == 0u) { if (xb_ld(&bar[XB_TMO])) break; if (sp > XB_SPIN_CAP) { atomicAdd(&bar[XB_TMO], 1u); break; } }
    }
    nloc = mine > 0u ? mine : 1u; nx = cnt > 0u ? cnt : 1u;
}

__device__ __forceinline__ void xcd_barrier(const XcdBarrier& b) {
    asm volatile("s_waitcnt vmcnt(0)" ::: "memory");
    __syncthreads();
    if (threadIdx.x == 0) {
        unsigned* bar = b.bar;
        __builtin_amdgcn_s_waitcnt(0);
        unsigned nloc = b.st[0], nx = b.st[1];
        if (nloc == 0u) { xcd_barrier_complete(bar, b.x, nloc, nx); b.st[0] = nloc; b.st[1] = nx; }
        const unsigned old = xb_add(&bar[XB_XSUB(b.x)], 1u);
        const unsigned gen = old / nloc;
        if (old + 1u == (gen + 1u) * nloc) {
            __builtin_amdgcn_fence(__ATOMIC_RELEASE, "agent");
            asm volatile("s_waitcnt vmcnt(0)" ::: "memory");
            const unsigned og = xb_add(&bar[XB_TOP], 1u);
            const unsigned tg = og / nx;
            if (og + 1u == (tg + 1u) * nx) xb_add(&bar[XB_TOPGEN], 1u);
            else XB_SPIN(xb_ld(&bar[XB_TOPGEN]) == tg, bar);
            __builtin_amdgcn_fence(__ATOMIC_ACQUIRE, "agent");
            xb_add(&bar[XB_XGEN(b.x)], 1u);
            asm volatile("s_waitcnt vmcnt(0)" ::: "memory");
        } else {
            XB_SPIN(xb_ld(&bar[XB_XGEN(b.x)]) == gen, bar);
            __builtin_amdgcn_fence(__ATOMIC_ACQUIRE, "agent");
            asm volatile("s_waitcnt vmcnt(0)" ::: "memory");
        }
    }
    __syncthreads();
}

using pg8::bf16_t; using pg8::bf16x8; using pg8::f32x4; using pg8::u32x4; using pg8::Unit;

typedef LAS unsigned char* ldsp;
typedef unsigned u32x2 __attribute__((ext_vector_type(2)));
typedef float f32x2v __attribute__((ext_vector_type(2)));

constexpr int D = 1024, NB = 8, SEQ = 4096, MTOT = NB * SEQ, DIN = 9216;
constexpr int MH = MTOT / 2;
constexpr float EPS = 1e-6f;
constexpr int C_HQ = 0, C_HF = 1024, C_HI = 2048, C_HZ = 3072, C_RQ = 4096, C_RK = 4608, C_RV = 5120, C_RZ = 6144, C_GA = 7168, C_GB = 8192;
constexpr int NSEG = 8, SEGLEN = 512, NCH = SEGLEN / 64;
constexpr size_t MiB = 1u << 20;
constexpr size_t WS_MOD = 0, WS_BAR = 106496, WS_LB = 131072, WS_ROPE = 262144, WS_WIN = 2 * MiB, WS_WOUT = 20 * MiB, WS_SLA = 22 * MiB, WS_SLB = 38 * MiB, WS_DA = 46 * MiB,
                 WS_H = 48 * MiB, WS_PROJ = 112 * MiB, WS_END = 400 * MiB;
constexpr int L_QT = 0, L_KT = 17408, L_KTT = 34816, L_VT = 53248, L_SM = 71680, L_AM = 106496, L_OF = 115712, L_SUB = 149504, L_EM = 153600, L_XB = 154624, LDS_BYTES = 154640;
constexpr int RS_D = 272, RS_S = 144, RS_O = 528;

__device__ __forceinline__ unsigned pkbf(float lo, float hi) { return pg8::cvt_pk_bf16(lo, hi); }
__device__ __forceinline__ float bflo(unsigned w) { return __uint_as_float(w << 16); }
__device__ __forceinline__ float bfhi(unsigned w) { return __uint_as_float(w & 0xffff0000u); }
__device__ __forceinline__ float ex2(float x) { return __builtin_amdgcn_exp2f(x); }
__device__ __forceinline__ float sigm(float x) { return __builtin_amdgcn_rcpf(1.0f + ex2(-1.4426950408889634f * x)); }
__device__ __forceinline__ float silu(float x) { return x * sigm(x); }

struct EpiProj {
    static constexpr bool PERM = true, AFTER_DRAIN = false;
    bf16_t* O; const float* lb; const float* rope;
    __device__ __forceinline__ void operator()(const f32x4 (&acc)[2][2][4][2], const Unit& u, int wr, int wc, int fr, int fq) const {
        const int pn = u.pn;
        const int mode = pn < 4 ? 1 : pn < 8 ? 2 : pn < 12 ? 0 : pn < 16 ? 1 : pn < 18 ? 3 : pn < 20 ? 4 : pn < 24 ? 0 : pn < 28 ? 1 : 5;
        const int row0 = u.pm * 256 + wr * 64 + fr;
        const int col0 = pn * 256 + wc * 32 + 8 * fq;
        f32x4 lbv[2][2];
#pragma unroll
        for (int bj = 0; bj < 2; ++bj)
#pragma unroll
            for (int n = 0; n < 2; ++n) lbv[bj][n] = (mode == 2) ? *(const f32x4*)(lb + (col0 - C_HF) + bj * 128 + 4 * n) : (f32x4){0.f, 0.f, 0.f, 0.f};
#pragma unroll
        for (int ai = 0; ai < 2; ++ai)
#pragma unroll
            for (int m = 0; m < 4; ++m) {
                const int row = row0 + ai * 128 + m * 16;
                bf16_t* rowp = O + (size_t)row * DIN + col0;
                f32x4 cs0 = (f32x4){1.f, 0.f, 1.f, 0.f}, cs1 = cs0;
                if (mode == 3 || mode == 4) { const float* rp = rope + ((size_t)(row & (SEQ - 1)) * 32 + ((col0 & 63) >> 1)) * 2; cs0 = *(const f32x4*)rp; cs1 = *(const f32x4*)(rp + 4); }
#pragma unroll
                for (int bj = 0; bj < 2; ++bj) {
                    f32x4 v0 = acc[ai][bj][m][0], v1 = acc[ai][bj][m][1];
                    if (mode == 1) {
#pragma unroll
                        for (int j = 0; j < 4; ++j) { v0[j] = silu(v0[j]); v1[j] = silu(v1[j]); }
                    } else if (mode == 5) {
#pragma unroll
                        for (int j = 0; j < 4; ++j) { v0[j] = sigm(v0[j]); v1[j] = sigm(v1[j]); }
                    } else if (mode == 2) {
#pragma unroll
                        for (int j = 0; j < 4; ++j) { const float l0 = lbv[bj][0][j], l1 = lbv[bj][1][j];
                            v0[j] = __builtin_amdgcn_logf(l0 + (1.0f - l0) * sigm(v0[j])); v1[j] = __builtin_amdgcn_logf(l1 + (1.0f - l1) * sigm(v1[j])); }
                    } else if (mode == 3 || mode == 4) {
                        const float sc = (mode == 4) ? 0.125f : 1.0f;
                        f32x4 r0, r1;
                        r0[0] = (v0[0] * cs0[0] - v0[1] * cs0[1]) * sc; r0[1] = (v0[0] * cs0[1] + v0[1] * cs0[0]) * sc;
                        r0[2] = (v0[2] * cs0[2] - v0[3] * cs0[3]) * sc; r0[3] = (v0[2] * cs0[3] + v0[3] * cs0[2]) * sc;
                        r1[0] = (v1[0] * cs1[0] - v1[1] * cs1[1]) * sc; r1[1] = (v1[0] * cs1[1] + v1[1] * cs1[0]) * sc;
                        r1[2] = (v1[2] * cs1[2] - v1[3] * cs1[3]) * sc; r1[3] = (v1[2] * cs1[3] + v1[3] * cs1[2]) * sc;
                        v0 = r0; v1 = r1;
                    }
                    u32x4 w; w.x = pkbf(v0[0], v0[1]); w.y = pkbf(v0[2], v0[3]); w.z = pkbf(v1[0], v1[1]); w.w = pkbf(v1[2], v1[3]);
                    __builtin_nontemporal_store(w, (u32x4*)(rowp + bj * 128));
                }
            }
    }
};
struct EpiRes {
    static constexpr bool PERM = false, AFTER_DRAIN = false;
    const float* x; float* out; const float* mod;
    __device__ __forceinline__ void operator()(const f32x4 (&acc)[2][2][4][2], const Unit& u, int wr, int wc, int fr, int fq) const {
        const int row0 = u.pm * 256 + wr * 64 + fr, col0 = u.pn * 256 + wc * 32 + 4 * fq;
        const int b = (u.pm * 256) / SEQ;
        const float* gate = mod + (size_t)b * 3 * D + 2 * D + col0;
        f32x4 gv[2][2];
#pragma unroll
        for (int bj = 0; bj < 2; ++bj)
#pragma unroll
            for (int n = 0; n < 2; ++n) gv[bj][n] = *(const f32x4*)(gate + bj * 128 + n * 16);
#pragma unroll
        for (int ai = 0; ai < 2; ++ai)
#pragma unroll
            for (int m = 0; m < 4; ++m) { const size_t off = (size_t)(row0 + ai * 128 + m * 16) * D + col0;
#pragma unroll
                for (int bj = 0; bj < 2; ++bj)
#pragma unroll
                    for (int n = 0; n < 2; ++n) { const f32x4 xs = *(const f32x4*)(x + off + bj * 128 + n * 16); *(f32x4*)(out + off + bj * 128 + n * 16) = xs + gv[bj][n] * acc[ai][bj][m][n]; }
                asm volatile("" ::: "memory"); }
    }
};

struct Params { const float* x; const float* c; const float* norm_g; const float* w_ada; const float* b_ada; const float* w_in; const float* lb_logits; const float* hg_norm_g;
                const float* ret_norm_g; const float* w_out; const float* final_g; float* out; unsigned char* ws; };

__device__ __forceinline__ void p0_mod(ldsp lds, const Params& p, int job) {
    const int tid = threadIdx.x, cl = tid & 63, ks = tid >> 6, n = job * 64 + cl;
    LAS float* sc = (LAS float*)lds;
    LAS float* red = (LAS float*)(lds + 32768);
    for (int i = tid; i < NB * D; i += 512) sc[i] = silu(p.c[i]);
    __syncthreads();
    float a[NB];
#pragma unroll
    for (int b = 0; b < NB; ++b) a[b] = 0.f;
    for (int k = ks * 128; k < ks * 128 + 128; ++k) { const float w = p.w_ada[(size_t)k * (3 * D) + n];
#pragma unroll
        for (int b = 0; b < NB; ++b) a[b] += sc[b * D + k] * w; }
#pragma unroll
    for (int b = 0; b < NB; ++b) red[(ks * NB + b) * 64 + cl] = a[b];
    __syncthreads();
    { const int b = tid >> 6; float s = p.b_ada[n];
#pragma unroll
      for (int q = 0; q < 8; ++q) s += red[(q * NB + b) * 64 + cl];
      ((float*)(p.ws + WS_MOD))[(size_t)b * 3 * D + n] = s; }
    __syncthreads();
}
__device__ __forceinline__ void p0_transpose(ldsp lds, const float* W, int N, bf16_t* Wt, int kt, int nt, bool permute) {
    const int tid = threadIdx.x; LAS float* t = (LAS float*)lds;
    const int nn = tid & 63; int src = nn;
    if (permute) src = (nn & 1) ? (nn >> 1) + 32 : (nn >> 1);
#pragma unroll
    for (int i = 0; i < 8; ++i) { const int kk = i * 8 + (tid >> 6); t[kk * 65 + nn] = W[(size_t)(kt * 64 + kk) * N + nt * 64 + src]; }
    __syncthreads();
    { const int n2 = tid >> 3, k8 = (tid & 7) * 8; float v[8];
#pragma unroll
      for (int i = 0; i < 8; ++i) v[i] = t[(k8 + i) * 65 + n2];
      u32x4 w; w.x = pkbf(v[0], v[1]); w.y = pkbf(v[2], v[3]); w.z = pkbf(v[4], v[5]); w.w = pkbf(v[6], v[7]);
      *(u32x4*)(Wt + (size_t)(nt * 64 + n2) * D + kt * 64 + k8) = w; }
    __syncthreads();
}
__device__ __forceinline__ void sincos_d(double r, double& s, double& c) {
    const double r2 = r * r; double cs = 1.0, sn = 1.0;
    double tc = 1.0, ts = 1.0;
#pragma unroll
    for (int k = 1; k <= 13; ++k) { tc *= -r2 / (double)((2 * k - 1) * (2 * k)); ts *= -r2 / (double)((2 * k) * (2 * k + 1)); cs += tc; sn += ts; }
    c = cs; s = sn * r;
}
__device__ __forceinline__ void p0_tables(const Params& p) {
    const int gt = blockIdx.x * 512 + threadIdx.x, gs = gridDim.x * 512;
    float* lb = (float*)(p.ws + WS_LB); float* rope = (float*)(p.ws + WS_ROPE);
    for (int i = gt; i < D; i += gs) { const float l0 = p.lb_logits[i], l1 = p.lb_logits[D + i]; const float mx = fmaxf(l0, l1); const float e0 = __expf(l0 - mx), e1 = __expf(l1 - mx); lb[i] = e0 / (e0 + e1); }
    for (int i = gt; i < SEQ * 32; i += gs) { const int pos = i >> 5, j = i & 31;
        const float ex = (float)j * (1.0f / 31.0f);
        const float invf = 1.0f / (float)exp((double)ex * 9.210340371976184);
        const float ang = (float)pos * invf;
        const double a = (double)ang; const double n = rint(a * 0.15915494309189535); const double r = fma(-n, 6.283185307179586, a) - n * 2.4492935982947064e-16;
        double s, c; sincos_d(r, s, c);
        rope[2 * i] = (float)c; rope[2 * i + 1] = (float)s; }
}
__device__ __forceinline__ void p0_hnorm(const Params& p) {
    const int lane = threadIdx.x & 63, wave = threadIdx.x >> 6;
    const float* mod = (const float*)(p.ws + WS_MOD); bf16_t* H = (bf16_t*)(p.ws + WS_H);
    for (int row = blockIdx.x * 8 + wave; row < MTOT; row += gridDim.x * 8) {
        const float* xr = p.x + (size_t)row * D; const int b = row / SEQ;
        f32x4 v[4]; float ss = 0.f;
#pragma unroll
        for (int i = 0; i < 4; ++i) { v[i] = *(const f32x4*)(xr + i * 256 + lane * 4); ss += v[i][0] * v[i][0] + v[i][1] * v[i][1] + v[i][2] * v[i][2] + v[i][3] * v[i][3]; }
#pragma unroll
        for (int o = 1; o < 64; o <<= 1) ss += __shfl_xor(ss, o);
        const float rstd = rsqrtf(ss * (1.0f / D) + EPS);
#pragma unroll
        for (int i = 0; i < 4; ++i) { const int c0 = i * 256 + lane * 4;
            const f32x4 g = *(const f32x4*)(p.norm_g + c0), sh = *(const f32x4*)(mod + (size_t)b * 3 * D + c0), sc = *(const f32x4*)(mod + (size_t)b * 3 * D + D + c0);
            const f32x4 hv = v[i] * rstd * g * (sc + 1.0f) + sh;
            u32x2 w; w.x = pkbf(hv[0], hv[1]); w.y = pkbf(hv[2], hv[3]);
            *(u32x2*)(H + (size_t)row * D + c0) = w; }
    }
}
__device__ __forceinline__ void p4_final(const Params& p) {
    const int lane = threadIdx.x & 63, wave = threadIdx.x >> 6;
    for (int row = blockIdx.x * 8 + wave; row < MTOT; row += gridDim.x * 8) {
        float* xr = p.out + (size_t)row * D;
        f32x4 v[4]; float ss = 0.f;
#pragma unroll
        for (int i = 0; i < 4; ++i) { v[i] = *(const f32x4*)(xr + i * 256 + lane * 4); ss += v[i][0] * v[i][0] + v[i][1] * v[i][1] + v[i][2] * v[i][2] + v[i][3] * v[i][3]; }
#pragma unroll
        for (int o = 1; o < 64; o <<= 1) ss += __shfl_xor(ss, o);
        const float rstd = rsqrtf(ss * (1.0f / D) + EPS);
#pragma unroll
        for (int i = 0; i < 4; ++i) { const int c0 = i * 256 + lane * 4; const f32x4 g = *(const f32x4*)(p.final_g + c0); *(f32x4*)(xr + c0) = v[i] * rstd * g; }
    }
}

template <bool OUT>
__device__ __forceinline__ void prep_hg(const int tid, ldsp lds, const bf16_t* P, int h, float& gs0, float& gs1) {
    const int dp = tid & 63, sub = tid >> 6, d = 2 * dp;
    const unsigned voff = (unsigned)(((8 * sub) * DIN + h * 128 + d) * 2);
    unsigned qv[8], gv[8], vv[8];
#pragma unroll
    for (int i = 0; i < 8; ++i) { const char* rb = (const char*)P + (size_t)i * (DIN * 2);
        qv[i] = OUT ? *(const unsigned*)(rb + C_HQ * 2 + voff) : 0u; gv[i] = *(const unsigned*)(rb + C_HF * 2 + voff); vv[i] = *(const unsigned*)(rb + C_HI * 2 + voff); }
    float b0[8], b1[8]; float r0 = 0.f, r1 = 0.f;
#pragma unroll
    for (int i = 0; i < 8; ++i) { r0 += bflo(gv[i]); b0[i] = r0; r1 += bfhi(gv[i]); b1[i] = r1; }
    LAS float* SUB = (LAS float*)(lds + L_SUB);
    *(LAS f32x2v*)(SUB + sub * 128 + d) = (f32x2v){r0, r1};
    __syncthreads();
    float p0 = 0.f, p1 = 0.f, m0 = 0.f, m1 = 0.f, t0 = 0.f, t1 = 0.f;
#pragma unroll
    for (int s = 0; s < 8; ++s) { const f32x2v x = *(const LAS f32x2v*)(SUB + s * 128 + d);
        if (s < sub) { p0 += x.x; p1 += x.y; } if (s < 4) { m0 += x.x; m1 += x.y; } t0 += x.x; t1 += x.y; }
    if (sub == 0) { LAS float* EM = (LAS float*)(lds + L_EM); EM[d] = ex2(m0); EM[d + 1] = ex2(m1); EM[128 + d] = ex2(t0 - m0); EM[128 + d + 1] = ex2(t1 - m1); }
    gs0 += t0; gs1 += t1;
    unsigned kt0[4], kt1[4], vt0[4], vt1[4]; float kp0 = 0.f, kp1 = 0.f;
#pragma unroll
    for (int i = 0; i < 8; ++i) { const int t = 8 * sub + i;
        const float x0 = fminf(fmaxf(p0 + b0[i] - m0, -115.f), 115.f), x1 = fminf(fmaxf(p1 + b1[i] - m1, -115.f), 115.f);
        const float k0 = (1.0f - ex2(bflo(gv[i]))) * ex2(-x0), k1 = (1.0f - ex2(bfhi(gv[i]))) * ex2(-x1);
        if (OUT) { *(LAS unsigned*)(lds + L_QT + t * RS_D + d * 2) = pkbf(bflo(qv[i]) * ex2(x0), bfhi(qv[i]) * ex2(x1));
                   *(LAS unsigned*)(lds + L_KT + t * RS_D + d * 2) = pkbf(k0, k1); }
        if (i & 1) { kt0[i >> 1] = pkbf(kp0, k0); kt1[i >> 1] = pkbf(kp1, k1);
                     vt0[i >> 1] = (vv[i - 1] & 0xffffu) | (vv[i] << 16); vt1[i >> 1] = (vv[i - 1] >> 16) | (vv[i] & 0xffff0000u); }
        else { kp0 = k0; kp1 = k1; } }
    *(LAS u32x4*)(lds + L_KTT + d * RS_S + sub * 16) = (u32x4){kt0[0], kt0[1], kt0[2], kt0[3]};
    *(LAS u32x4*)(lds + L_KTT + (d + 1) * RS_S + sub * 16) = (u32x4){kt1[0], kt1[1], kt1[2], kt1[3]};
    *(LAS u32x4*)(lds + L_VT + d * RS_S + sub * 16) = (u32x4){vt0[0], vt0[1], vt0[2], vt0[3]};
    *(LAS u32x4*)(lds + L_VT + (d + 1) * RS_S + sub * 16) = (u32x4){vt1[0], vt1[1], vt1[2], vt1[3]};
}
template <bool OUT>
__device__ __forceinline__ void prep_rt(const int tid, ldsp lds, const bf16_t* P, int h, float lg) {
    { const int dp = tid & 31, sub = tid >> 5, d = 2 * dp;
      const unsigned voff = (unsigned)(((4 * sub) * DIN + h * 64 + d) * 2);
      unsigned qv[4], kv[4];
#pragma unroll
      for (int i = 0; i < 4; ++i) { const char* rb = (const char*)P + (size_t)i * (DIN * 2);
          qv[i] = OUT ? *(const unsigned*)(rb + C_RQ * 2 + voff) : 0u; kv[i] = *(const unsigned*)(rb + C_RK * 2 + voff); }
      unsigned kt0[2], kt1[2]; float kp0 = 0.f, kp1 = 0.f;
#pragma unroll
      for (int i = 0; i < 4; ++i) { const int t = 4 * sub + i; const float ek = ex2((float)(31 - t) * lg);
          const float k0 = bflo(kv[i]) * ek, k1 = bfhi(kv[i]) * ek;
          if (OUT) { const float eq = ex2((float)(t - 31) * lg);
                     *(LAS unsigned*)(lds + L_QT + t * RS_D + d * 2) = pkbf(bflo(qv[i]) * eq, bfhi(qv[i]) * eq);
                     *(LAS unsigned*)(lds + L_KT + t * RS_D + d * 2) = pkbf(k0, k1); }
          if (i & 1) { kt0[i >> 1] = pkbf(kp0, k0); kt1[i >> 1] = pkbf(kp1, k1); } else { kp0 = k0; kp1 = k1; } }
      *(LAS u32x2*)(lds + L_KTT + d * RS_S + sub * 8) = (u32x2){kt0[0], kt0[1]};
      *(LAS u32x2*)(lds + L_KTT + (d + 1) * RS_S + sub * 8) = (u32x2){kt1[0], kt1[1]}; }
    { const int ep = tid & 63, sub = tid >> 6, e = 2 * ep;
      const unsigned voff = (unsigned)(((8 * sub) * DIN + h * 128 + e) * 2);
      unsigned vv[8], vt0[4], vt1[4];
#pragma unroll
      for (int i = 0; i < 8; ++i) vv[i] = *(const unsigned*)((const char*)P + (size_t)i * (DIN * 2) + C_RV * 2 + voff);
#pragma unroll
      for (int i = 0; i < 4; ++i) { vt0[i] = (vv[2 * i] & 0xffffu) | (vv[2 * i + 1] << 16); vt1[i] = (vv[2 * i] >> 16) | (vv[2 * i + 1] & 0xffff0000u); }
      *(LAS u32x4*)(lds + L_VT + e * RS_S + sub * 16) = (u32x4){vt0[0], vt0[1], vt0[2], vt0[3]};
      *(LAS u32x4*)(lds + L_VT + (e + 1) * RS_S + sub * 16) = (u32x4){vt1[0], vt1[1], vt1[2], vt1[3]}; }
    if (tid < 64) { const float e32 = ex2(32.0f * lg); LAS float* EM = (LAS float*)(lds + L_EM); EM[tid] = e32; EM[128 + tid] = e32; }
}
template <int DK, bool OUT>
__device__ __forceinline__ void mix_core(const int tid, ldsp lds, f32x4 (&S)[DK == 128 ? 8 : 4]) {
    constexpr int NE = DK == 128 ? 8 : 4;
    const int w = __builtin_amdgcn_readfirstlane(tid >> 6), lane = tid & 63, l15 = lane & 15, quad = lane >> 4;
    const int db = DK == 128 ? w : (w & 3), eb0 = DK == 128 ? 0 : (w >> 2) * 4;
    __syncthreads();
    { const f32x4 em4 = *(const LAS f32x4*)(lds + L_EM + (db * 16 + quad * 4) * 4);
#pragma unroll
      for (int i = 0; i < NE; ++i) S[i] *= em4; }
    if (OUT) {
#pragma unroll
        for (int i = 0; i < NE; ++i) *(LAS u32x2*)(lds + L_SM + ((eb0 + i) * 16 + l15) * RS_D + (db * 16 + quad * 4) * 2) = (u32x2){pkbf(S[i][0], S[i][1]), pkbf(S[i][2], S[i][3])};
        const int tb = w & 3;
#pragma unroll
        for (int si = 0; si < 2; ++si) { const int sb = (w >> 2) * 2 + si; f32x4 a = (f32x4){0.f, 0.f, 0.f, 0.f};
            if (sb <= tb) {
#pragma unroll
                for (int ks = 0; ks < DK / 32; ++ks) { const bf16x8 af = *(const LAS bf16x8*)(lds + L_QT + (tb * 16 + l15) * RS_D + (ks * 32 + quad * 8) * 2);
                    const bf16x8 bf = *(const LAS bf16x8*)(lds + L_KT + (sb * 16 + l15) * RS_D + (ks * 32 + quad * 8) * 2);
                    a = __builtin_amdgcn_mfma_f32_16x16x32_bf16(af, bf, a, 0, 0, 0); }
            }
#pragma unroll
            for (int j = 0; j < 4; ++j) { const int t = tb * 16 + quad * 4 + j, s = sb * 16 + l15; const float v = (s <= t) ? a[j] : 0.f;
                *(LAS unsigned short*)(lds + L_AM + t * RS_S + s * 2) = (unsigned short)(pkbf(v, 0.f) & 0xffffu); }
        }
        __syncthreads();
        f32x4 o[4];
#pragma unroll
        for (int i = 0; i < 4; ++i) o[i] = (f32x4){0.f, 0.f, 0.f, 0.f};
        const int oe0 = (w >> 2) * 4;
#pragma unroll
        for (int ks = 0; ks < DK / 32; ++ks) { const bf16x8 af = *(const LAS bf16x8*)(lds + L_QT + (tb * 16 + l15) * RS_D + (ks * 32 + quad * 8) * 2);
#pragma unroll
            for (int i = 0; i < 4; ++i) { const bf16x8 bf = *(const LAS bf16x8*)(lds + L_SM + ((oe0 + i) * 16 + l15) * RS_D + (ks * 32 + quad * 8) * 2);
                o[i] = __builtin_amdgcn_mfma_f32_16x16x32_bf16(af, bf, o[i], 0, 0, 0); }
            __builtin_amdgcn_sched_barrier(0); }
#pragma unroll
        for (int ks = 0; ks < 2; ++ks) { const bf16x8 af = *(const LAS bf16x8*)(lds + L_AM + (tb * 16 + l15) * RS_S + (ks * 32 + quad * 8) * 2);
#pragma unroll
            for (int i = 0; i < 4; ++i) { const bf16x8 bf = *(const LAS bf16x8*)(lds + L_VT + ((oe0 + i) * 16 + l15) * RS_S + (ks * 32 + quad * 8) * 2);
                o[i] = __builtin_amdgcn_mfma_f32_16x16x32_bf16(af, bf, o[i], 0, 0, 0); }
            __builtin_amdgcn_sched_barrier(0); }
#pragma unroll
        for (int i = 0; i < 4; ++i)
#pragma unroll
            for (int j = 0; j < 4; ++j) *(LAS float*)(lds + L_OF + (tb * 16 + quad * 4 + j) * RS_O + ((oe0 + i) * 16 + l15) * 4) = o[i][j];
    }
#pragma unroll
    for (int ks = 0; ks < 2; ++ks) { const bf16x8 af = *(const LAS bf16x8*)(lds + L_KTT + (db * 16 + l15) * RS_S + (ks * 32 + quad * 8) * 2);
#pragma unroll
        for (int i = 0; i < NE; ++i) { const bf16x8 bf = *(const LAS bf16x8*)(lds + L_VT + ((eb0 + i) * 16 + l15) * RS_S + (ks * 32 + quad * 8) * 2);
            S[i] = __builtin_amdgcn_mfma_f32_16x16x32_bf16(af, bf, S[i], 0, 0, 0); }
        __builtin_amdgcn_sched_barrier(0); }
    { const f32x4 ed4 = *(const LAS f32x4*)(lds + L_EM + (128 + db * 16 + quad * 4) * 4);
#pragma unroll
      for (int i = 0; i < NE; ++i) S[i] *= ed4; }
    __syncthreads();
}
__device__ __forceinline__ void epi_mix(const int tid, ldsp lds, const bf16_t* Prow, int zcol, int gcol, const float* gn, float (&am)[16], bool first) {
    const int t = tid >> 3, c = tid & 7;
    f32x4 o[4]; float ss = 0.f;
#pragma unroll
    for (int i = 0; i < 4; ++i) { o[i] = *(const LAS f32x4*)(lds + L_OF + t * RS_O + c * 64 + i * 16); ss += o[i][0] * o[i][0] + o[i][1] * o[i][1] + o[i][2] * o[i][2] + o[i][3] * o[i][3]; }
    ss += __shfl_xor(ss, 1); ss += __shfl_xor(ss, 2); ss += __shfl_xor(ss, 4);
    const float rstd = rsqrtf(ss * (1.0f / 128.0f) + EPS);
    const unsigned voff = (unsigned)((t * DIN + 16 * c) * 2);
    const u32x4 z0 = *(const u32x4*)((const char*)Prow + zcol * 2 + voff), z1 = *(const u32x4*)((const char*)Prow + zcol * 2 + 16 + voff);
    const u32x4 g0 = *(const u32x4*)((const char*)Prow + gcol * 2 + voff), g1 = *(const u32x4*)((const char*)Prow + gcol * 2 + 16 + voff);
#pragma unroll
    for (int i = 0; i < 4; ++i) { const f32x4 gg = *(const f32x4*)(gn + 16 * c + 4 * i);
        const unsigned zw0 = i < 2 ? z0[2 * i] : z1[2 * i - 4], zw1 = i < 2 ? z0[2 * i + 1] : z1[2 * i - 3];
        const unsigned gw0 = i < 2 ? g0[2 * i] : g1[2 * i - 4], gw1 = i < 2 ? g0[2 * i + 1] : g1[2 * i - 3];
        const float v0 = o[i][0] * rstd * gg[0] * bflo(zw0) * bflo(gw0), v1 = o[i][1] * rstd * gg[1] * bfhi(zw0) * bfhi(gw0);
        const float v2 = o[i][2] * rstd * gg[2] * bflo(zw1) * bflo(gw1), v3 = o[i][3] * rstd * gg[3] * bfhi(zw1) * bfhi(gw1);
        if (first) { am[4 * i] = v0; am[4 * i + 1] = v1; am[4 * i + 2] = v2; am[4 * i + 3] = v3; }
        else { am[4 * i] += v0; am[4 * i + 1] += v1; am[4 * i + 2] += v2; am[4 * i + 3] += v3; } }
}

__device__ __forceinline__ void p2a(ldsp lds, const Params& p) {
    const bf16_t* proj = (const bf16_t*)(p.ws + WS_PROJ);
    int tid_ = threadIdx.x; asm volatile("" : "+v"(tid_)); const int tid = tid_;
    for (int u = blockIdx.x; u < 256; u += gridDim.x) {
        const int seg = u & 7, h = (u >> 3) & 7, bl = u >> 6;
        if (seg == NSEG - 1) continue;
        const float lg = log1pf(-exp2f(-5.0f - (float)h)) * 1.4426950408889634f;
        f32x4 SA[8], SB[4];
#pragma unroll
        for (int i = 0; i < 8; ++i) SA[i] = (f32x4){0.f, 0.f, 0.f, 0.f};
#pragma unroll
        for (int i = 0; i < 4; ++i) SB[i] = (f32x4){0.f, 0.f, 0.f, 0.f};
        float gs0 = 0.f, gs1 = 0.f;
        const size_t row0 = (size_t)bl * SEQ + (size_t)seg * SEGLEN;
        for (int c = 0; c < NCH; ++c) { const bf16_t* P = proj + (row0 + (size_t)c * 64) * DIN;
            prep_hg<false>(tid, lds, P, h, gs0, gs1); mix_core<128, false>(tid, lds, SA);
            prep_rt<false>(tid, lds, P, h, lg);       mix_core<64, false>(tid, lds, SB); }
        float* sla = (float*)(p.ws + WS_SLA) + (size_t)u * 16384; float* slb = (float*)(p.ws + WS_SLB) + (size_t)u * 8192; float* da = (float*)(p.ws + WS_DA) + (size_t)u * 128;
#pragma unroll
        for (int i = 0; i < 8; ++i) *(f32x4*)((char*)sla + (unsigned)(tid * 128 + i * 16)) = SA[i];
#pragma unroll
        for (int i = 0; i < 4; ++i) *(f32x4*)((char*)slb + (unsigned)(tid * 64 + i * 16)) = SB[i];
        if (tid < 64) { da[2 * tid] = ex2(gs0); da[2 * tid + 1] = ex2(gs1); }
    }
}
__device__ __forceinline__ void p2b(ldsp lds, const Params& p, int half) {
    const bf16_t* proj = (const bf16_t*)(p.ws + WS_PROJ);
    bf16_t* Mo = (bf16_t*)(p.ws + WS_H) + (size_t)half * MH * D;
    int tid_ = threadIdx.x; asm volatile("" : "+v"(tid_)); const int tid = tid_, w = __builtin_amdgcn_readfirstlane(tid >> 6), lane = tid & 63, quad = lane >> 4;
    for (int u = blockIdx.x; u < 256; u += gridDim.x) {
        const int seg = u & 7, h = (u >> 3) & 7, bl = u >> 6;
        const float lg = log1pf(-exp2f(-5.0f - (float)h)) * 1.4426950408889634f;
        const float dB = ex2((float)SEGLEN * lg);
        f32x4 SA[8], SB[4];
#pragma unroll
        for (int i = 0; i < 8; ++i) SA[i] = (f32x4){0.f, 0.f, 0.f, 0.f};
#pragma unroll
        for (int i = 0; i < 4; ++i) SB[i] = (f32x4){0.f, 0.f, 0.f, 0.f};
        for (int s = 0; s < seg; ++s) { const int uu = u - seg + s;
            const float* sla = (const float*)(p.ws + WS_SLA) + (size_t)uu * 16384; const float* slb = (const float*)(p.ws + WS_SLB) + (size_t)uu * 8192;
            const f32x4 d4 = *(const f32x4*)((const float*)(p.ws + WS_DA) + (size_t)uu * 128 + w * 16 + quad * 4);
#pragma unroll
            for (int i = 0; i < 8; ++i) SA[i] = SA[i] * d4 + *(const f32x4*)((const char*)sla + (unsigned)(tid * 128 + i * 16));
#pragma unroll
            for (int i = 0; i < 4; ++i) SB[i] = SB[i] * dB + *(const f32x4*)((const char*)slb + (unsigned)(tid * 64 + i * 16)); }
        float gs0 = 0.f, gs1 = 0.f;
        const size_t row0 = (size_t)bl * SEQ + (size_t)seg * SEGLEN;
        const int t = tid >> 3, c8 = tid & 7;
        for (int c = 0; c < NCH; ++c) { const bf16_t* P = proj + (row0 + (size_t)c * 64) * DIN;
            float am[16];
            prep_hg<true>(tid, lds, P, h, gs0, gs1); mix_core<128, true>(tid, lds, SA);
            epi_mix(tid, lds, P + h * 128, C_HZ, C_GA, p.hg_norm_g + h * 128, am, true);
            prep_rt<true>(tid, lds, P, h, lg);       mix_core<64, true>(tid, lds, SB);
            epi_mix(tid, lds, P + h * 128, C_RZ, C_GB, p.ret_norm_g + h * 128, am, false);
            bf16_t* mo = Mo + (row0 + (size_t)c * 64 + t) * D + h * 128 + 16 * c8;
            *(u32x4*)mo = (u32x4){pkbf(am[0], am[1]), pkbf(am[2], am[3]), pkbf(am[4], am[5]), pkbf(am[6], am[7])};
            *(u32x4*)(mo + 8) = (u32x4){pkbf(am[8], am[9]), pkbf(am[10], am[11]), pkbf(am[12], am[13]), pkbf(am[14], am[15])};
        }
    }
}

#ifndef REP_P0A
#define REP_P0A 1
#endif
#ifndef REP_P0B
#define REP_P0B 1
#endif
#ifndef REP_P3
#define REP_P3 1
#endif
#ifndef REP_P1
#define REP_P1 1
#endif
#ifndef REP_P2A
#define REP_P2A 1
#endif
#ifndef REP_P2B
#define REP_P2B 1
#endif
__global__ void __launch_bounds__(512, 2) fwd_megakernel(Params p) {
    extern __shared__ __attribute__((aligned(16))) unsigned char lds_raw[];
    ldsp lds = (ldsp)lds_raw;
    cg::grid_group grid = cg::this_grid();
    const int G = gridDim.x;
    if (threadIdx.x == 0) *(LAS u32x4*)(lds + L_XB) = (u32x4){0u, 0u, 0u, 0u};
    __syncthreads();
    const XcdBarrier xbar = xcd_barrier_post((unsigned*)(p.ws + WS_BAR), (volatile LAS unsigned*)(lds + L_XB));
#define GSYNC() xcd_barrier(xbar)
    for (int r_ = 0; r_ < REP_P0A; ++r_) {
    for (int j = blockIdx.x; j < 48; j += G) p0_mod(lds, p, j);
    p0_tables(p);
    for (int tI = blockIdx.x; tI < 144 * 16 + 16 * 16; tI += G) {
        if (tI < 144 * 16) { const int nt = tI / 16, kt = tI % 16; p0_transpose(lds, p.w_in, DIN, (bf16_t*)(p.ws + WS_WIN), kt, nt, nt >= C_RQ / 64 && nt < C_RV / 64); }
        else { const int q = tI - 144 * 16; p0_transpose(lds, p.w_out, D, (bf16_t*)(p.ws + WS_WOUT), q % 16, q / 16, false); }
    }
    if (G == 0x7fffffff) grid.sync();
    GSYNC(); }
    for (int r_ = 0; r_ < REP_P0B; ++r_) p0_hnorm(p);
    GSYNC();
    for (int half = 0; half < 2; ++half) {
        for (int r_ = 0; r_ < REP_P1; ++r_) { pg8::Gemm g{(const bf16_t*)(p.ws + WS_H) + (size_t)half * MH * D, (const bf16_t*)(p.ws + WS_WIN), MH, DIN, D};
          pg8::StaticOrder S; S.init(MH, DIN, G, (int)blockIdx.x);
          EpiProj E{(bf16_t*)(p.ws + WS_PROJ), (const float*)(p.ws + WS_LB), (const float*)(p.ws + WS_ROPE)};
          pg8::gemm_phase<EpiProj, pg8::StaticOrder, false>(lds, g, S, E, nullptr); if (r_ + 1 < REP_P1) GSYNC(); }
        GSYNC();
        for (int r_ = 0; r_ < REP_P2A; ++r_) { p2a(lds, p); if (r_ + 1 < REP_P2A) GSYNC(); }
        GSYNC();
        for (int r_ = 0; r_ < REP_P2B; ++r_) { p2b(lds, p, half); if (r_ + 1 < REP_P2B) GSYNC(); }
        GSYNC();
    }
    for (int r_ = 0; r_ < REP_P3; ++r_) { pg8::Gemm g{(const bf16_t*)(p.ws + WS_H), (const bf16_t*)(p.ws + WS_WOUT), MTOT, D, D};
      pg8::StaticOrder S; S.init(MTOT, D, G, (int)blockIdx.x);
      EpiRes E{p.x, p.out, (const float*)(p.ws + WS_MOD)};
      pg8::gemm_phase<EpiRes, pg8::StaticOrder, false>(lds, g, S, E, nullptr); if (r_ + 1 < REP_P3) GSYNC(); }
    GSYNC();
    p4_final(p);
}

extern "C" void kernel_launch(void* const* d_in, const int* in_sizes, int n_in, void* d_out, int out_size, void* d_ws, size_t ws_size, hipStream_t stream) {
    static int grid = 0;
    if (grid == 0) {
        if (n_in != 11 || out_size != MTOT * D || ws_size < WS_END) { fprintf(stderr, "kernel_launch: unexpected shapes (n_in %d out %d ws %zu)\n", n_in, out_size, ws_size); grid = -1; return; }
        int dev = 0, cus = 0, per_cu = 0;
        hipGetDevice(&dev); hipDeviceGetAttribute(&cus, hipDeviceAttributeMultiprocessorCount, dev);
        if (hipFuncSetAttribute((const void*)fwd_megakernel, hipFuncAttributeMaxDynamicSharedMemorySize, LDS_BYTES) != hipSuccess) { fprintf(stderr, "kernel_launch: hipFuncSetAttribute failed\n"); grid = -1; return; }
        if (hipOccupancyMaxActiveBlocksPerMultiprocessor(&per_cu, (const void*)fwd_megakernel, 512, LDS_BYTES) != hipSuccess || per_cu < 1) { fprintf(stderr, "kernel_launch: occupancy query failed (%d)\n", per_cu); per_cu = 1; }
        (void)hipGetLastError();
        grid = cus;
        fprintf(stderr, "kernel_launch: cus %d per_cu %d grid %d\n", cus, per_cu, grid);
    }
    if (grid < 0) return;
    Params p{};
    p.x = (const float*)d_in[0]; p.c = (const float*)d_in[1]; p.norm_g = (const float*)d_in[2]; p.w_ada = (const float*)d_in[3]; p.b_ada = (const float*)d_in[4];
    p.w_in = (const float*)d_in[5]; p.lb_logits = (const float*)d_in[6]; p.hg_norm_g = (const float*)d_in[7]; p.ret_norm_g = (const float*)d_in[8]; p.w_out = (const float*)d_in[9];
    p.final_g = (const float*)d_in[10]; p.out = (float*)d_out; p.ws = (unsigned char*)d_ws;
    if (hipMemsetAsync((char*)d_ws + WS_BAR, 0, XCD_BAR_WORDS * 4, stream) != hipSuccess) { fprintf(stderr, "kernel_launch: memset failed\n"); return; }
    void* args[] = {&p};
    hipError_t e = hipLaunchCooperativeKernel((const void*)fwd_megakernel, dim3(grid), dim3(512), args, LDS_BYTES, stream);
    if (e != hipSuccess) fprintf(stderr, "kernel_launch: cooperative launch failed: %s (grid %d)\n", hipGetErrorString(e), grid);
}
```

```cpp
#include <hip/hip_runtime.h>
#include <hip/hip_cooperative_groups.h>
#include <cstdio>
namespace cg = cooperative_groups;
#define LAS __attribute__((address_space(3)))
namespace pg8 {
#define PG8_LAS __attribute__((address_space(3)))
typedef unsigned short bf16_t;
typedef short bf16x8 __attribute__((ext_vector_type(8)));
typedef float f32x4 __attribute__((ext_vector_type(4)));
typedef unsigned u32x4 __attribute__((ext_vector_type(4)));
constexpr int BM = 256, BK = 64, HALF = 128, HTB = HALF * BK * 2  , STAGE_BYTES = 8 * HTB, NXCD = 8, WGM = 8;

__host__ __device__ __forceinline__ int lds_byte(int r, int c) { const int st = (r >> 4) * 2 + (c >> 5), rr = r & 15, cc = c & 31, ob = rr * 64 + cc * 2; return st * 1024 + (ob ^ (((ob >> 9) & 1) << 5)); }
__host__ __device__ __forceinline__ void stage_rc(int b, int& R, int& C) { const int st = b / 1024, sb = b % 1024, swz = sb ^ (((sb >> 9) & 1) << 5); R = (st >> 1) * 16 + swz / 64; C = (st & 1) * 32 + (swz % 64) / 2; }
__host__ __device__ __forceinline__ int perm32(int rho) { const int n = rho >> 4, i = rho & 15; return 8 * (i >> 2) + 4 * n + (i & 3); }

struct Unit { int pm, pn; };
struct Gemm { const bf16_t* A; const bf16_t* Bt; int M, N, K; };
struct StaticOrder {
    int nM, nN, nwg, G, c;
    __host__ __device__ void init(int M, int N, int G_, int c_) { nM = M / BM; nN = N / BM; nwg = nM * nN; G = G_; c = c_; }
    __host__ __device__ bool next(int i, Unit& u) const {
        const long L = (long)i * G + c; if (L >= nwg) return false;
        int wgid = (int)L; { const int q = nwg / NXCD, r = nwg % NXCD, xcd = wgid % NXCD, off = wgid / NXCD; wgid = (xcd < r ? xcd * (q + 1) : r * (q + 1) + (xcd - r) * q) + off; }
        const int nig = WGM * nN, gid = wgid / nig, fm = gid * WGM, gsz = (nM - fm) < WGM ? (nM - fm) : WGM;
        u.pm = fm + ((wgid % nig) % gsz); u.pn = (wgid % nig) / gsz; return true;
    }
    __device__ __forceinline__ void a_ready(const Unit&) const {}
    __device__ __forceinline__ void done(const Unit&) const {}
};
__device__ __forceinline__ unsigned cvt_pk_bf16(float lo, float hi) { unsigned r; asm volatile("v_cvt_pk_bf16_f32 %0, %1, %2" : "=v"(r) : "v"(lo), "v"(hi)); return r; }
typedef float f32x2 __attribute__((ext_vector_type(2)));
template <class Epi, class Sched, bool STAMP = false>
__device__ __forceinline__ void gemm_phase(const int tid, PG8_LAS unsigned char* lds, const Gemm g, const Sched& S, const Epi& E, unsigned long long* stamps) {
    const int wid = __builtin_amdgcn_readfirstlane(tid >> 6), lane = tid & 63, wr = wid >> 2, wc = wid & 3, fr = lane & 15, fq = lane >> 4;
    const int K = g.K, nt = K / BK;
    int ts_lo = 0, ts_hi = 0, nts = 0; const unsigned long long rt_entry = STAMP ? (unsigned long long)wall_clock64() : 0ull;
#define PG8_STAMP() do { if (STAMP && wid == 0 && nts < 64) { const unsigned long long _c = (unsigned long long)clock64(); \
        ts_lo = (lane == nts) ? (int)(unsigned)_c : ts_lo; ts_hi = (lane == nts) ? (int)(unsigned)(_c >> 32) : ts_hi; ++nts; } } while (0)
    PG8_STAMP();
    unsigned voffA[2], voffB[2];
#pragma unroll
    for (int i = 0; i < 2; ++i) { int R, C; stage_rc(tid * 16 + i * 8192, R, C); const int Rb = Epi::PERM ? ((R & ~31) + perm32(R & 31)) : R;
        voffA[i] = (unsigned)(R * K + C) * 2u; voffB[i] = (unsigned)(Rb * K + C) * 2u; }
    const size_t kstep = (size_t)(BK * 2);
    const size_t hstep = (size_t)HALF * K * 2;
    const size_t tstep = 2 * hstep;
    const unsigned ldsw = (unsigned)wid * 1024u;
    const int aoff = lds_byte(wr * 64 + fr, fq * 8), boff = lds_byte(wc * 32 + fr, fq * 8);
#define PG8_SA(b, h) (((b) * 2 + (h)) * HTB)
#define PG8_SB(b, h) ((4 + (b) * 2 + (h)) * HTB)
#define PG8_STAGE(bufoff, gbase, voff) do { _Pragma("unroll") for (int _i = 0; _i < 2; ++_i) \
        __builtin_amdgcn_global_load_lds((const unsigned*)((const char*)(gbase) + (voff)[_i]), (PG8_LAS unsigned*)(lds + (bufoff) + ldsw + _i * 8192), 16, 0, 0); } while (0)
#define PG8_LDA(dst, b, h) do { _Pragma("unroll") for (int m = 0; m < 4; ++m) _Pragma("unroll") for (int k = 0; k < 2; ++k) dst[m][k] = *(const PG8_LAS bf16x8*)(lds + PG8_SA(b, h) + aoff + m * 2048 + k * 1024); } while (0)
#define PG8_LDB(dst, b, h) do { _Pragma("unroll") for (int n = 0; n < 2; ++n) _Pragma("unroll") for (int k = 0; k < 2; ++k) dst[n][k] = *(const PG8_LAS bf16x8*)(lds + PG8_SB(b, h) + boff + n * 2048 + k * 1024); } while (0)
#define PG8_MMA(ai, bj, At, Bt) do { __builtin_amdgcn_s_setprio(1); _Pragma("unroll") for (int m = 0; m < 4; ++m) _Pragma("unroll") for (int n = 0; n < 2; ++n) _Pragma("unroll") for (int k = 0; k < 2; ++k) \
        acc[ai][bj][m][n] = __builtin_amdgcn_mfma_f32_16x16x32_bf16(Bt[n][k], At[m][k], acc[ai][bj][m][n], 0, 0, 0); __builtin_amdgcn_s_setprio(0); } while (0)
#define PG8_WAIT_V(n) asm volatile("s_waitcnt vmcnt(" #n ")" ::: "memory")
#define PG8_WAIT_L(n) asm volatile("s_waitcnt lgkmcnt(" #n ")" ::: "memory")
#define PG8_BAR __builtin_amdgcn_s_barrier()
#define PG8_SCHED __builtin_amdgcn_sched_barrier(0)
    Unit cur, nxt; int ui = 0;
    if (!S.next(0, cur)) return;
    f32x4 acc[2][2][4][2];
#pragma unroll
    for (int a = 0; a < 2; ++a)
#pragma unroll
        for (int b = 0; b < 2; ++b)
#pragma unroll
            for (int m = 0; m < 4; ++m)
#pragma unroll
                for (int n = 0; n < 2; ++n) acc[a][b][m][n] = (f32x4){0.f, 0.f, 0.f, 0.f};
    bf16x8 At[4][2], B0[2][2], B1[2][2];
    const char* cA = (const char*)g.A + (size_t)cur.pm * tstep; const char* cB = (const char*)g.Bt + (size_t)cur.pn * tstep;
    S.a_ready(cur);
    PG8_STAGE(PG8_SB(0, 0), cB, voffB); PG8_STAGE(PG8_SA(0, 0), cA, voffA); PG8_STAGE(PG8_SB(0, 1), cB + hstep, voffB); PG8_STAGE(PG8_SA(0, 1), cA + hstep, voffA);
    if (wr == 1) PG8_BAR;
    PG8_WAIT_V(4); PG8_BAR;
    PG8_STAGE(PG8_SB(1, 0), cB + kstep, voffB); PG8_STAGE(PG8_SA(1, 0), cA + kstep, voffA); PG8_STAGE(PG8_SB(1, 1), cB + hstep + kstep, voffB);
    PG8_WAIT_V(6); PG8_BAR;
    PG8_STAMP();
    for (;;) {
        const bool has_next = S.next(ui + 1, nxt);
        const char* nA = has_next ? (const char*)g.A + (size_t)nxt.pm * tstep : cA; const char* nB = has_next ? (const char*)g.Bt + (size_t)nxt.pn * tstep : cB;
        for (int t = 0; t < nt; t += 2) {
            const bool last = (t == nt - 2);
            const char* a1 = cA + (size_t)(t + 1) * kstep;
            const char* a2 = last ? nA : cA + (size_t)(t + 2) * kstep; const char* b2 = last ? nB : cB + (size_t)(t + 2) * kstep;
            const char* a3 = a2 + kstep; const char* b3 = b2 + kstep;
            if (last && has_next) S.a_ready(nxt);
            PG8_LDB(B0, 0, 0); PG8_SCHED; PG8_LDA(At, 0, 0); PG8_STAGE(PG8_SA(1, 1), a1 + hstep, voffA);
            PG8_WAIT_L(8); PG8_BAR; PG8_WAIT_L(0); PG8_MMA(0, 0, At, B0); PG8_BAR; PG8_SCHED;
            PG8_LDB(B1, 0, 1); PG8_STAGE(PG8_SB(0, 0), b2, voffB);
            PG8_BAR; PG8_WAIT_L(0); PG8_MMA(0, 1, At, B1); PG8_BAR;
            PG8_LDA(At, 0, 1); PG8_STAGE(PG8_SA(0, 0), a2, voffA);
            PG8_BAR; PG8_WAIT_L(0); PG8_MMA(1, 0, At, B0); PG8_BAR; PG8_SCHED;
            PG8_STAGE(PG8_SB(0, 1), b2 + hstep, voffB);
            PG8_WAIT_V(6); PG8_BAR; PG8_MMA(1, 1, At, B1); PG8_BAR;
            PG8_LDB(B0, 1, 0); PG8_SCHED; PG8_LDA(At, 1, 0); PG8_STAGE(PG8_SA(0, 1), a2 + hstep, voffA);
            PG8_WAIT_L(8); PG8_BAR; PG8_WAIT_L(0); PG8_MMA(0, 0, At, B0); PG8_BAR; PG8_SCHED;
            PG8_LDB(B1, 1, 1); PG8_STAGE(PG8_SB(1, 0), b3, voffB);
            PG8_BAR; PG8_WAIT_L(0); PG8_MMA(0, 1, At, B1); PG8_BAR;
            PG8_LDA(At, 1, 1); PG8_STAGE(PG8_SA(1, 0), a3, voffA);
            PG8_BAR; PG8_WAIT_L(0); PG8_MMA(1, 0, At, B0); PG8_BAR; PG8_SCHED;
            PG8_STAGE(PG8_SB(1, 1), b3 + hstep, voffB);
            PG8_WAIT_V(6); PG8_BAR; PG8_MMA(1, 1, At, B1); PG8_BAR;
        }
        PG8_STAMP();
        if constexpr (!Epi::AFTER_DRAIN) { E(acc, cur, wr, wc, fr, fq); S.done(cur); }
        PG8_STAMP();
        if (!has_next) break;
#pragma unroll
        for (int a = 0; a < 2; ++a)
#pragma unroll
            for (int b = 0; b < 2; ++b)
#pragma unroll
                for (int m = 0; m < 4; ++m)
#pragma unroll
                    for (int n = 0; n < 2; ++n) acc[a][b][m][n] = (f32x4){0.f, 0.f, 0.f, 0.f};
        cur = nxt; cA = nA; cB = nB; ++ui;
    }
    PG8_WAIT_V(0);
    if (wr == 0) PG8_BAR;
    PG8_BAR;
    if constexpr (Epi::AFTER_DRAIN) { E.fused(acc, cur, wr, wc, fr, fq, lds, wid, lane); S.done(cur); }
    PG8_STAMP();
    if (STAMP && wid == 0) { stamps[lane] = lane < nts ? (((unsigned long long)(unsigned)ts_hi << 32) | (unsigned)ts_lo) : 0ull;
        if (lane == 62) stamps[62] = rt_entry; if (lane == 63) stamps[63] = (unsigned long long)wall_clock64(); }
#undef PG8_STAMP
#undef PG8_SA
#undef PG8_SB
#undef PG8_STAGE
#undef PG8_LDA
#undef PG8_LDB
#undef PG8_MMA
#undef PG8_WAIT_V
#undef PG8_WAIT_L
#undef PG8_BAR
#undef PG8_SCHED
}
}
#define XB_TMO      128
#define XB_XCNT(j)  (256  + 64 * (j))
#define XB_XSUB(j)  (1280 + 64 * (j))
#define XB_XGEN(j)  (2304 + 64 * (j))
#define XB_TOP      3328
#define XB_TOPGEN   3392
#define XCD_BAR_WORDS 3456
#define XB_SPIN_CAP (1u << 18)

__device__ __forceinline__ unsigned xb_ld(unsigned* p)              { return __hip_atomic_load(p, __ATOMIC_RELAXED, __HIP_MEMORY_SCOPE_AGENT); }
__device__ __forceinline__ unsigned xb_add(unsigned* p, unsigned v) { return __hip_atomic_fetch_add(p, v, __ATOMIC_RELAXED, __HIP_MEMORY_SCOPE_AGENT); }
__device__ __forceinline__ unsigned xb_xcc_id() { return (unsigned)__builtin_amdgcn_s_getreg((3 << 11) | 20) & 0xFu; }
#define XB_SPIN(cond, bar) do { unsigned _sp = 0; while (cond) { __builtin_amdgcn_s_sleep(1); \
    if ((++_sp & 255u) == 0u) { if (xb_ld(&(bar)[XB_TMO])) break; if (_sp > XB_SPIN_CAP) { atomicAdd(&(bar)[XB_TMO], 1u); break; } } } } while (0)

struct XcdBarrier {
    unsigned* bar; unsigned x;
    volatile LAS unsigned* st;
};

__device__ __forceinline__ XcdBarrier xcd_barrier_post(unsigned* bar, volatile LAS unsigned* st, const bool lead) {
    XcdBarrier b; b.bar = bar; b.x = xb_xcc_id(); b.st = st;
    if (lead) (void)xb_add(&bar[XB_XCNT(b.x)], 1u);
    return b;
}
__device__ __forceinline__ void xcd_barrier_complete(unsigned* bar, unsigned x, unsigned& nloc, unsigned& nx) {
    const unsigned G = gridDim.x * gridDim.y * gridDim.z;
    unsigned sum, cnt, mine, sp = 0u;
    for (;;) {
        sum = 0u; cnt = 0u; mine = 0u;
#pragma unroll
        for (unsigned j = 0; j < 16; ++j) { const unsigned c = xb_ld(&bar[XB_XCNT(j)]); sum += c; cnt += (c > 0u) ? 1u : 0u; mine = (j == x) ? c : mine; }
        if (sum == G) break;
        __builtin_amdgcn_s_sleep(1);
        if ((++sp & 255u) == 0u) { if (xb_ld(&bar[XB_TMO])) break; if (sp > XB_SPIN_CAP) { atomicAdd(&bar[XB_TMO], 1u); break; } }
    }
    nloc = mine > 0u ? mine : 1u; nx = cnt > 0u ? cnt : 1u;
}

__device__ __forceinline__ void xcd_barrier(const XcdBarrier& b, const bool lead) {
    asm volatile("s_waitcnt vmcnt(0)" ::: "memory");
    __syncthreads();
    if (lead) {
        unsigned* bar = b.bar;
        __builtin_amdgcn_s_waitcnt(0);
        unsigned nloc = b.st[0], nx = b.st[1];
        if (nloc == 0u) { xcd_barrier_complete(bar, b.x, nloc, nx); b.st[0] = nloc; b.st[1] = nx; }
        const unsigned old = xb_add(&bar[XB_XSUB(b.x)], 1u);
        const unsigned gen = old / nloc;
        if (old + 1u == (gen + 1u) * nloc) {
            __builtin_amdgcn_fence(__ATOMIC_RELEASE, "agent");
            asm volatile("s_waitcnt vmcnt(0)" ::: "memory");
            const unsigned og = xb_add(&bar[XB_TOP], 1u);
            const unsigned tg = og / nx;
            if (og + 1u == (tg + 1u) * nx) xb_add(&bar[XB_TOPGEN], 1u);
            else XB_SPIN(xb_ld(&bar[XB_TOPGEN]) == tg, bar);
            __builtin_amdgcn_fence(__ATOMIC_ACQUIRE, "agent");
            xb_add(&bar[XB_XGEN(b.x)], 1u);
            asm volatile("s_waitcnt vmcnt(0)" ::: "memory");
        } else {
            XB_SPIN(xb_ld(&bar[XB_XGEN(b.x)]) == gen, bar);
            __builtin_amdgcn_fence(__ATOMIC_ACQUIRE, "agent");
            asm volatile("s_waitcnt vmcnt(0)" ::: "memory");
        }
    }
    __syncthreads();
}

using pg8::bf16_t; using pg8::bf16x8; using pg8::f32x4; using pg8::u32x4; using pg8::Unit;

typedef LAS unsigned char* ldsp;
typedef unsigned u32x2 __attribute__((ext_vector_type(2)));
typedef float f32x2v __attribute__((ext_vector_type(2)));
typedef __fp16 h16x2 __attribute__((ext_vector_type(2)));

constexpr int D = 1024, NB = 8, SEQ = 4096, MTOT = NB * SEQ, DIN = 9216;
constexpr int MH = MTOT / 2;
constexpr float EPS = 1e-6f;
constexpr int C_HQ = 0, C_HF = 1024, C_HI = 2048, C_HZ = 3072, C_RQ = 4096, C_RK = 4608, C_RV = 5120, C_RZ = 6144, C_GA = 7168, C_GB = 8192;
constexpr int NSEG = 8, SEGLEN = 512, NCH = SEGLEN / 64;
constexpr size_t MiB = 1u << 20;
constexpr size_t WS_MOD = 0, WS_BAR = 106496, WS_LB = 131072, WS_ROPE = 262144, WS_WIN = 2 * MiB, WS_WOUT = 20 * MiB, WS_SLA = 22 * MiB, WS_SLB = 38 * MiB, WS_DA = 46 * MiB,
                 WS_H = 48 * MiB, WS_PROJ = 112 * MiB, WS_END = 400 * MiB;
constexpr int L_QT = 0, L_KT = 17408, L_KTT = 34816, L_VT = 53248, L_SM = 71680, L_AM = 106496, L_OF = 115712, L_SUB = 149504, L_EM = 153600, L_XB = 154624, L_GN = 154640, LDS_BYTES = 155664;
constexpr int RS_D = 272, RS_S = 144, RS_O = 528;

__device__ __forceinline__ unsigned pkbf(float lo, float hi) { return pg8::cvt_pk_bf16(lo, hi); }
__device__ __forceinline__ float bflo(unsigned w) { return __uint_as_float(w << 16); }
__device__ __forceinline__ float bfhi(unsigned w) { return __uint_as_float(w & 0xffff0000u); }
__device__ __forceinline__ float ex2(float x) { return __builtin_amdgcn_exp2f(x); }
__device__ __forceinline__ float sigm(float x) { return __builtin_amdgcn_rcpf(1.0f + ex2(-1.4426950408889634f * x)); }
__device__ __forceinline__ float silu(float x) { return x * sigm(x); }

struct EpiProj {
    static constexpr bool PERM = true, AFTER_DRAIN = false;
    bf16_t* O; const float* lb; const float* rope;
    __device__ __forceinline__ void operator()(const f32x4 (&acc)[2][2][4][2], const Unit& u, int wr, int wc, int fr, int fq) const {
        const int pn = u.pn;
        const int mode = pn < 4 ? 1 : pn < 8 ? 2 : pn < 12 ? 0 : pn < 16 ? 1 : pn < 18 ? 3 : pn < 20 ? 4 : pn < 24 ? 0 : pn < 28 ? 1 : 5;
        const int row0 = u.pm * 256 + wr * 64 + fr;
        const int col0 = pn * 256 + wc * 32 + 8 * fq;
        f32x4 lbv[2][2];
#pragma unroll
        for (int bj = 0; bj < 2; ++bj)
#pragma unroll
            for (int n = 0; n < 2; ++n) lbv[bj][n] = (mode == 2) ? *(const f32x4*)(lb + (col0 - C_HF) + bj * 128 + 4 * n) : (f32x4){0.f, 0.f, 0.f, 0.f};
#pragma unroll
        for (int ai = 0; ai < 2; ++ai)
#pragma unroll
            for (int m = 0; m < 4; ++m) {
                const int row = row0 + ai * 128 + m * 16;
                bf16_t* rowp = O + (size_t)row * DIN + col0;
                f32x4 cs0 = (f32x4){1.f, 0.f, 1.f, 0.f}, cs1 = cs0;
                if (mode == 3 || mode == 4) { const float* rp = rope + ((size_t)(row & (SEQ - 1)) * 32 + ((col0 & 63) >> 1)) * 2; cs0 = *(const f32x4*)rp; cs1 = *(const f32x4*)(rp + 4); }
#pragma unroll
                for (int bj = 0; bj < 2; ++bj) {
                    f32x4 v0 = acc[ai][bj][m][0], v1 = acc[ai][bj][m][1];
                    if (mode == 1) {
#pragma unroll
                        for (int j = 0; j < 4; ++j) { v0[j] = silu(v0[j]); v1[j] = silu(v1[j]); }
                    } else if (mode == 5) {
#pragma unroll
                        for (int j = 0; j < 4; ++j) { v0[j] = sigm(v0[j]); v1[j] = sigm(v1[j]); }
                    } else if (mode == 2) {
#pragma unroll
                        for (int j = 0; j < 4; ++j) { const float l0 = lbv[bj][0][j], l1 = lbv[bj][1][j];
                            v0[j] = __builtin_amdgcn_logf(l0 + (1.0f - l0) * sigm(v0[j])); v1[j] = __builtin_amdgcn_logf(l1 + (1.0f - l1) * sigm(v1[j])); }
                    } else if (mode == 3 || mode == 4) {
                        const float sc = (mode == 4) ? 0.125f : 1.0f;
                        f32x4 r0, r1;
                        r0[0] = (v0[0] * cs0[0] - v0[1] * cs0[1]) * sc; r0[1] = (v0[0] * cs0[1] + v0[1] * cs0[0]) * sc;
                        r0[2] = (v0[2] * cs0[2] - v0[3] * cs0[3]) * sc; r0[3] = (v0[2] * cs0[3] + v0[3] * cs0[2]) * sc;
                        r1[0] = (v1[0] * cs1[0] - v1[1] * cs1[1]) * sc; r1[1] = (v1[0] * cs1[1] + v1[1] * cs1[0]) * sc;
                        r1[2] = (v1[2] * cs1[2] - v1[3] * cs1[3]) * sc; r1[3] = (v1[2] * cs1[3] + v1[3] * cs1[2]) * sc;
                        v0 = r0; v1 = r1;
                    }
                    u32x4 w; w.x = pkbf(v0[0], v0[1]); w.y = pkbf(v0[2], v0[3]); w.z = pkbf(v1[0], v1[1]); w.w = pkbf(v1[2], v1[3]);
                    __builtin_nontemporal_store(w, (u32x4*)(rowp + bj * 128));
                }
            }
    }
};
struct EpiRes {
    static constexpr bool PERM = false, AFTER_DRAIN = false;
    const float* x; float* out; const float* mod;
    __device__ __forceinline__ void operator()(const f32x4 (&acc)[2][2][4][2], const Unit& u, int wr, int wc, int fr, int fq) const {
        const int row0 = u.pm * 256 + wr * 64 + fr, col0 = u.pn * 256 + wc * 32 + 4 * fq;
        const int b = (u.pm * 256) / SEQ;
        const float* gate = mod + (size_t)b * 3 * D + 2 * D + col0;
        f32x4 gv[2][2];
#pragma unroll
        for (int bj = 0; bj < 2; ++bj)
#pragma unroll
            for (int n = 0; n < 2; ++n) gv[bj][n] = *(const f32x4*)(gate + bj * 128 + n * 16);
#pragma unroll
        for (int ai = 0; ai < 2; ++ai)
#pragma unroll
            for (int m = 0; m < 4; ++m) { const size_t off = (size_t)(row0 + ai * 128 + m * 16) * D + col0;
#pragma unroll
                for (int bj = 0; bj < 2; ++bj)
#pragma unroll
                    for (int n = 0; n < 2; ++n) { const f32x4 xs = *(const f32x4*)(x + off + bj * 128 + n * 16); *(f32x4*)(out + off + bj * 128 + n * 16) = xs + gv[bj][n] * acc[ai][bj][m][n]; }
                asm volatile("" ::: "memory"); }
    }
};

struct Params { const float* x; const float* c; const float* norm_g; const float* w_ada; const float* b_ada; const float* w_in; const float* lb_logits; const float* hg_norm_g;
                const float* ret_norm_g; const float* w_out; const float* final_g; float* out; unsigned char* ws; };

__device__ __forceinline__ void p0_mod(const int tid, ldsp lds, const Params& p, int job) {
    const int cl = tid & 63, ks = tid >> 6, n = job * 64 + cl;
    LAS float* sc = (LAS float*)lds;
    LAS float* red = (LAS float*)(lds + 32768);
    for (int i = tid; i < NB * D; i += 512) sc[i] = silu(p.c[i]);
    __syncthreads();
    float a[NB];
#pragma unroll
    for (int b = 0; b < NB; ++b) a[b] = 0.f;
    for (int k = ks * 128; k < ks * 128 + 128; ++k) { const float w = p.w_ada[(size_t)k * (3 * D) + n];
#pragma unroll
        for (int b = 0; b < NB; ++b) a[b] += sc[b * D + k] * w; }
#pragma unroll
    for (int b = 0; b < NB; ++b) red[(ks * NB + b) * 64 + cl] = a[b];
    __syncthreads();
    { const int b = tid >> 6; float s = p.b_ada[n];
#pragma unroll
      for (int q = 0; q < 8; ++q) s += red[(q * NB + b) * 64 + cl];
      ((float*)(p.ws + WS_MOD))[(size_t)b * 3 * D + n] = s; }
    __syncthreads();
}
__device__ __forceinline__ void p0_transpose(const int tid, ldsp lds, const float* W, int N, bf16_t* Wt, int kt, int nt, bool permute) {
    LAS float* t = (LAS float*)lds;
    const int nn = tid & 63; int src = nn;
    if (permute) src = (nn & 1) ? (nn >> 1) + 32 : (nn >> 1);
#pragma unroll
    for (int i = 0; i < 8; ++i) { const int kk = i * 8 + (tid >> 6); t[kk * 65 + nn] = W[(size_t)(kt * 64 + kk) * N + nt * 64 + src]; }
    __syncthreads();
    { const int n2 = tid >> 3, k8 = (tid & 7) * 8; float v[8];
#pragma unroll
      for (int i = 0; i < 8; ++i) v[i] = t[(k8 + i) * 65 + n2];
      u32x4 w; w.x = pkbf(v[0], v[1]); w.y = pkbf(v[2], v[3]); w.z = pkbf(v[4], v[5]); w.w = pkbf(v[6], v[7]);
      *(u32x4*)(Wt + (size_t)(nt * 64 + n2) * D + kt * 64 + k8) = w; }
    __syncthreads();
}
__device__ __forceinline__ void sincos_d(double r, double& s, double& c) {
    const double r2 = r * r; double cs = 1.0, sn = 1.0;
    double tc = 1.0, ts = 1.0;
#pragma unroll
    for (int k = 1; k <= 13; ++k) { tc *= -r2 / (double)((2 * k - 1) * (2 * k)); ts *= -r2 / (double)((2 * k) * (2 * k + 1)); cs += tc; sn += ts; }
    c = cs; s = sn * r;
}
__device__ __forceinline__ void p0_tables(const int tid_, const Params& p) {
    const int gt = blockIdx.x * 512 + tid_, gs = gridDim.x * 512;
    float* lb = (float*)(p.ws + WS_LB); float* rope = (float*)(p.ws + WS_ROPE);
    for (int i = gt; i < D; i += gs) { const float l0 = p.lb_logits[i], l1 = p.lb_logits[D + i]; const float mx = fmaxf(l0, l1); const float e0 = __expf(l0 - mx), e1 = __expf(l1 - mx); lb[i] = e0 / (e0 + e1); }
    for (int i = gt; i < SEQ * 32; i += gs) { const int pos = i >> 5, j = i & 31;
        const float ex = (float)j * (1.0f / 31.0f);
        const float invf = 1.0f / (float)exp((double)ex * 9.210340371976184);
        const float ang = (float)pos * invf;
        const double a = (double)ang; const double n = rint(a * 0.15915494309189535); const double r = fma(-n, 6.283185307179586, a) - n * 2.4492935982947064e-16;
        double s, c; sincos_d(r, s, c);
        rope[2 * i] = (float)c; rope[2 * i + 1] = (float)s; }
}
__device__ __forceinline__ void p0_hnorm(const int tid_, const Params& p) {
    const int lane = tid_ & 63, wave = tid_ >> 6;
    const float* mod = (const float*)(p.ws + WS_MOD); bf16_t* H = (bf16_t*)(p.ws + WS_H);
    for (int row = blockIdx.x * 8 + wave; row < MTOT; row += gridDim.x * 8) {
        const float* xr = p.x + (size_t)row * D; const int b = row / SEQ;
        f32x4 v[4]; float ss = 0.f;
#pragma unroll
        for (int i = 0; i < 4; ++i) { v[i] = *(const f32x4*)(xr + i * 256 + lane * 4); ss += v[i][0] * v[i][0] + v[i][1] * v[i][1] + v[i][2] * v[i][2] + v[i][3] * v[i][3]; }
#pragma unroll
        for (int o = 1; o < 64; o <<= 1) ss += __shfl_xor(ss, o);
        const float rstd = rsqrtf(ss * (1.0f / D) + EPS);
#pragma unroll
        for (int i = 0; i < 4; ++i) { const int c0 = i * 256 + lane * 4;
            const f32x4 g = *(const f32x4*)(p.norm_g + c0), sh = *(const f32x4*)(mod + (size_t)b * 3 * D + c0), sc = *(const f32x4*)(mod + (size_t)b * 3 * D + D + c0);
            const f32x4 hv = v[i] * rstd * g * (sc + 1.0f) + sh;
            u32x2 w; w.x = pkbf(hv[0], hv[1]); w.y = pkbf(hv[2], hv[3]);
            *(u32x2*)(H + (size_t)row * D + c0) = w; }
    }
}
__device__ __forceinline__ void p4_final(const int tid_, const Params& p) {
    const int lane = tid_ & 63, wave = tid_ >> 6;
    for (int row = blockIdx.x * 8 + wave; row < MTOT; row += gridDim.x * 8) {
        float* xr = p.out + (size_t)row * D;
        f32x4 v[4]; float ss = 0.f;
#pragma unroll
        for (int i = 0; i < 4; ++i) { v[i] = *(const f32x4*)(xr + i * 256 + lane * 4); ss += v[i][0] * v[i][0] + v[i][1] * v[i][1] + v[i][2] * v[i][2] + v[i][3] * v[i][3]; }
#pragma unroll
        for (int o = 1; o < 64; o <<= 1) ss += __shfl_xor(ss, o);
        const float rstd = rsqrtf(ss * (1.0f / D) + EPS);
#pragma unroll
        for (int i = 0; i < 4; ++i) { const int c0 = i * 256 + lane * 4; const f32x4 g = *(const f32x4*)(p.final_g + c0); *(f32x4*)(xr + c0) = v[i] * rstd * g; }
    }
}

template <bool OUT, int WHICH = 3>
__device__ __forceinline__ void load_hg(const int tid, const bf16_t* P, int h, unsigned (&qv)[8], unsigned (&gv)[8], unsigned (&vv)[8]) {
    const int dp = tid & 63, sub = tid >> 6, d = 2 * dp;
    const unsigned voff = (unsigned)(((8 * sub) * DIN + h * 128 + d) * 2);
#pragma unroll
    for (int i = 0; i < 8; ++i) { const char* rb = (const char*)P + (size_t)i * (DIN * 2);
        if (WHICH & 2) qv[i] = OUT ? *(const unsigned*)(rb + C_HQ * 2 + voff) : 0u;
        if (WHICH & 1) { gv[i] = *(const unsigned*)(rb + C_HF * 2 + voff); vv[i] = *(const unsigned*)(rb + C_HI * 2 + voff); } }
}
template <bool OUT>
__device__ __forceinline__ void prep_hg(const int tid, ldsp lds, const unsigned (&qv)[8], const unsigned (&gv)[8], const unsigned (&vv)[8], float& gs0, float& gs1) {
    const int dp = tid & 63, sub = tid >> 6, d = 2 * dp;
    float b0[8], b1[8]; float r0 = 0.f, r1 = 0.f;
#pragma unroll
    for (int i = 0; i < 8; ++i) { r0 += bflo(gv[i]); b0[i] = r0; r1 += bfhi(gv[i]); b1[i] = r1; }
    LAS float* SUB = (LAS float*)(lds + L_SUB);
    *(LAS f32x2v*)(SUB + sub * 128 + d) = (f32x2v){r0, r1};
    __syncthreads();
    float p0 = 0.f, p1 = 0.f, m0 = 0.f, m1 = 0.f, t0 = 0.f, t1 = 0.f;
#pragma unroll
    for (int s = 0; s < 8; ++s) { const f32x2v x = *(const LAS f32x2v*)(SUB + s * 128 + d);
        if (s < sub) { p0 += x.x; p1 += x.y; } if (s < 4) { m0 += x.x; m1 += x.y; } t0 += x.x; t1 += x.y; }
    if (sub == 0) { LAS float* EM = (LAS float*)(lds + L_EM); EM[d] = ex2(m0); EM[d + 1] = ex2(m1); EM[128 + d] = ex2(t0 - m0); EM[128 + d + 1] = ex2(t1 - m1); }
    if (!OUT) { gs0 += t0; gs1 += t1; }
    unsigned kt0[4], kt1[4], vt0[4], vt1[4]; float kp0 = 0.f, kp1 = 0.f;
#pragma unroll
    for (int i = 0; i < 8; ++i) { const int t = 8 * sub + i;
        const float x0 = fminf(fmaxf(p0 + b0[i] - m0, -115.f), 115.f), x1 = fminf(fmaxf(p1 + b1[i] - m1, -115.f), 115.f);
        const float k0 = (1.0f - ex2(bflo(gv[i]))) * ex2(-x0), k1 = (1.0f - ex2(bfhi(gv[i]))) * ex2(-x1);
        if (OUT) { *(LAS unsigned*)(lds + L_QT + t * RS_D + d * 2) = pkbf(bflo(qv[i]) * ex2(x0), bfhi(qv[i]) * ex2(x1));
                   *(LAS unsigned*)(lds + L_KT + t * RS_D + d * 2) = pkbf(k0, k1); }
        if (i & 1) { kt0[i >> 1] = pkbf(kp0, k0); kt1[i >> 1] = pkbf(kp1, k1);
                     vt0[i >> 1] = (vv[i - 1] & 0xffffu) | (vv[i] << 16); vt1[i >> 1] = (vv[i - 1] >> 16) | (vv[i] & 0xffff0000u); }
        else { kp0 = k0; kp1 = k1; } }
    *(LAS u32x4*)(lds + L_KTT + d * RS_S + sub * 16) = (u32x4){kt0[0], kt0[1], kt0[2], kt0[3]};
    *(LAS u32x4*)(lds + L_KTT + (d + 1) * RS_S + sub * 16) = (u32x4){kt1[0], kt1[1], kt1[2], kt1[3]};
    *(LAS u32x4*)(lds + L_VT + d * RS_S + sub * 16) = (u32x4){vt0[0], vt0[1], vt0[2], vt0[3]};
    *(LAS u32x4*)(lds + L_VT + (d + 1) * RS_S + sub * 16) = (u32x4){vt1[0], vt1[1], vt1[2], vt1[3]};
}
template <bool OUT, int WHICH = 3>
__device__ __forceinline__ void load_rt(const int tid, const bf16_t* P, int h, unsigned (&qv)[4], unsigned (&kv)[4], unsigned (&vv)[8]) {
    { const int dp = tid & 31, sub = tid >> 5, d = 2 * dp;
      const unsigned voff = (unsigned)(((4 * sub) * DIN + h * 64 + d) * 2);
#pragma unroll
      for (int i = 0; i < 4; ++i) { const char* rb = (const char*)P + (size_t)i * (DIN * 2);
          if (WHICH & 2) qv[i] = OUT ? *(const unsigned*)(rb + C_RQ * 2 + voff) : 0u;
          if (WHICH & 1) kv[i] = *(const unsigned*)(rb + C_RK * 2 + voff); } }
    if (WHICH & 1) { const int ep = tid & 63, sub = tid >> 6, e = 2 * ep;
      const unsigned voff = (unsigned)(((8 * sub) * DIN + h * 128 + e) * 2);
#pragma unroll
      for (int i = 0; i < 8; ++i) vv[i] = *(const unsigned*)((const char*)P + (size_t)i * (DIN * 2) + C_RV * 2 + voff); }
}
template <bool OUT>
__device__ __forceinline__ void prep_rt(const int tid, ldsp lds, const unsigned (&qv)[4], const unsigned (&kv)[4], const unsigned (&vv)[8], float lg) {
    { const int dp = tid & 31, sub = tid >> 5, d = 2 * dp;
      unsigned kt0[2], kt1[2]; float kp0 = 0.f, kp1 = 0.f;
#pragma unroll
      for (int i = 0; i < 4; ++i) { const int t = 4 * sub + i; const float ek = ex2((float)(31 - t) * lg);
          const float k0 = bflo(kv[i]) * ek, k1 = bfhi(kv[i]) * ek;
          if (OUT) { const float eq = ex2((float)(t - 31) * lg);
                     *(LAS unsigned*)(lds + L_QT + t * RS_D + d * 2) = pkbf(bflo(qv[i]) * eq, bfhi(qv[i]) * eq);
                     *(LAS unsigned*)(lds + L_KT + t * RS_D + d * 2) = pkbf(k0, k1); }
          if (i & 1) { kt0[i >> 1] = pkbf(kp0, k0); kt1[i >> 1] = pkbf(kp1, k1); } else { kp0 = k0; kp1 = k1; } }
      *(LAS u32x2*)(lds + L_KTT + d * RS_S + sub * 8) = (u32x2){kt0[0], kt0[1]};
      *(LAS u32x2*)(lds + L_KTT + (d + 1) * RS_S + sub * 8) = (u32x2){kt1[0], kt1[1]}; }
    { const int ep = tid & 63, sub = tid >> 6, e = 2 * ep;
      unsigned vt0[4], vt1[4];
#pragma unroll
      for (int i = 0; i < 4; ++i) { vt0[i] = (vv[2 * i] & 0xffffu) | (vv[2 * i + 1] << 16); vt1[i] = (vv[2 * i] >> 16) | (vv[2 * i + 1] & 0xffff0000u); }
      *(LAS u32x4*)(lds + L_VT + e * RS_S + sub * 16) = (u32x4){vt0[0], vt0[1], vt0[2], vt0[3]};
      *(LAS u32x4*)(lds + L_VT + (e + 1) * RS_S + sub * 16) = (u32x4){vt1[0], vt1[1], vt1[2], vt1[3]}; }
    if (tid < 64) { const float e32 = ex2(32.0f * lg); LAS float* EM = (LAS float*)(lds + L_EM); EM[tid] = e32; EM[128 + tid] = e32; }
}
template <int DK, bool OUT>
__device__ __forceinline__ void mix_core(const int tid, ldsp lds, f32x4 (&S)[DK == 128 ? 8 : 4]) {
    constexpr int NE = DK == 128 ? 8 : 4;
    const int w = __builtin_amdgcn_readfirstlane(tid >> 6), lane = tid & 63, l15 = lane & 15, quad = lane >> 4;
    const int db = DK == 128 ? w : (w & 3), eb0 = DK == 128 ? 0 : (w >> 2) * 4;
    __syncthreads();
    { const f32x4 em4 = *(const LAS f32x4*)(lds + L_EM + (db * 16 + quad * 4) * 4);
#pragma unroll
      for (int i = 0; i < NE; ++i) S[i] *= em4; }
    if (OUT) {
#pragma unroll
        for (int i = 0; i < NE; ++i) *(LAS u32x2*)(lds + L_SM + ((eb0 + i) * 16 + l15) * RS_D + (db * 16 + quad * 4) * 2) = (u32x2){pkbf(S[i][0], S[i][1]), pkbf(S[i][2], S[i][3])};
        const int tb = w & 3;
#pragma unroll
        for (int si = 0; si < 2; ++si) { const int sb = (w >> 2) * 2 + si; f32x4 a = (f32x4){0.f, 0.f, 0.f, 0.f};
            if (sb <= tb) {
#pragma unroll
                for (int ks = 0; ks < DK / 32; ++ks) { const bf16x8 af = *(const LAS bf16x8*)(lds + L_QT + (tb * 16 + l15) * RS_D + (ks * 32 + quad * 8) * 2);
                    const bf16x8 bf = *(const LAS bf16x8*)(lds + L_KT + (sb * 16 + l15) * RS_D + (ks * 32 + quad * 8) * 2);
                    a = __builtin_amdgcn_mfma_f32_16x16x32_bf16(af, bf, a, 0, 0, 0); }
            }
#pragma unroll
            for (int j = 0; j < 4; ++j) { const int t = tb * 16 + quad * 4 + j, s = sb * 16 + l15; const float v = (s <= t) ? a[j] : 0.f;
                *(LAS unsigned short*)(lds + L_AM + t * RS_S + s * 2) = (unsigned short)(pkbf(v, 0.f) & 0xffffu); }
        }
        __syncthreads();
        f32x4 o[4];
#pragma unroll
        for (int i = 0; i < 4; ++i) o[i] = (f32x4){0.f, 0.f, 0.f, 0.f};
        const int oe0 = (w >> 2) * 4;
#pragma unroll
        for (int ks = 0; ks < DK / 32; ++ks) { const bf16x8 af = *(const LAS bf16x8*)(lds + L_QT + (tb * 16 + l15) * RS_D + (ks * 32 + quad * 8) * 2);
#pragma unroll
            for (int i = 0; i < 4; ++i) { const bf16x8 bf = *(const LAS bf16x8*)(lds + L_SM + ((oe0 + i) * 16 + l15) * RS_D + (ks * 32 + quad * 8) * 2);
                o[i] = __builtin_amdgcn_mfma_f32_16x16x32_bf16(af, bf, o[i], 0, 0, 0); }
            __builtin_amdgcn_sched_barrier(0); }
#pragma unroll
        for (int ks = 0; ks < 2; ++ks) { const bf16x8 af = *(const LAS bf16x8*)(lds + L_AM + (tb * 16 + l15) * RS_S + (ks * 32 + quad * 8) * 2);
#pragma unroll
            for (int i = 0; i < 4; ++i) { const bf16x8 bf = *(const LAS bf16x8*)(lds + L_VT + ((oe0 + i) * 16 + l15) * RS_S + (ks * 32 + quad * 8) * 2);
                o[i] = __builtin_amdgcn_mfma_f32_16x16x32_bf16(af, bf, o[i], 0, 0, 0); }
            __builtin_amdgcn_sched_barrier(0); }
#pragma unroll
        for (int i = 0; i < 4; ++i)
#pragma unroll
            for (int j = 0; j < 4; ++j) *(LAS float*)(lds + L_OF + (tb * 16 + quad * 4 + j) * RS_O + ((oe0 + i) * 16 + l15) * 4) = o[i][j];
    }
#pragma unroll
    for (int ks = 0; ks < 2; ++ks) { const bf16x8 af = *(const LAS bf16x8*)(lds + L_KTT + (db * 16 + l15) * RS_S + (ks * 32 + quad * 8) * 2);
#pragma unroll
        for (int i = 0; i < NE; ++i) { const bf16x8 bf = *(const LAS bf16x8*)(lds + L_VT + ((eb0 + i) * 16 + l15) * RS_S + (ks * 32 + quad * 8) * 2);
            S[i] = __builtin_amdgcn_mfma_f32_16x16x32_bf16(af, bf, S[i], 0, 0, 0); }
        __builtin_amdgcn_sched_barrier(0); }
    { const f32x4 ed4 = *(const LAS f32x4*)(lds + L_EM + (128 + db * 16 + quad * 4) * 4);
#pragma unroll
      for (int i = 0; i < NE; ++i) S[i] *= ed4; }
    __syncthreads();
}
__device__ __forceinline__ void load_gates(const int tid, const bf16_t* Prow, int zcol, int gcol, u32x4& z0, u32x4& z1, u32x4& g0, u32x4& g1) {
    const int t = tid >> 3, c = tid & 7;
    const unsigned voff = (unsigned)((t * DIN + 16 * c) * 2);
    z0 = *(const u32x4*)((const char*)Prow + zcol * 2 + voff); z1 = *(const u32x4*)((const char*)Prow + zcol * 2 + 16 + voff);
    g0 = *(const u32x4*)((const char*)Prow + gcol * 2 + voff); g1 = *(const u32x4*)((const char*)Prow + gcol * 2 + 16 + voff);
}
__device__ __forceinline__ void epi_mix(const int tid, ldsp lds, const u32x4 z0, const u32x4 z1, const u32x4 g0, const u32x4 g1, int gnoff, h16x2 (&am)[8], float (&res)[16], bool first) {
    const int t = tid >> 3, c = tid & 7;
    f32x4 o[4]; float ss = 0.f;
#pragma unroll
    for (int i = 0; i < 4; ++i) { o[i] = *(const LAS f32x4*)(lds + L_OF + t * RS_O + c * 64 + i * 16); ss += o[i][0] * o[i][0] + o[i][1] * o[i][1] + o[i][2] * o[i][2] + o[i][3] * o[i][3]; }
    ss += __shfl_xor(ss, 1); ss += __shfl_xor(ss, 2); ss += __shfl_xor(ss, 4);
    const float rstd = rsqrtf(ss * (1.0f / 128.0f) + EPS);
#pragma unroll
    for (int i = 0; i < 4; ++i) { const f32x4 gg = *(const LAS f32x4*)(lds + L_GN + gnoff + (16 * c + 4 * i) * 4);
        const unsigned zw0 = i < 2 ? z0[2 * i] : z1[2 * i - 4], zw1 = i < 2 ? z0[2 * i + 1] : z1[2 * i - 3];
        const unsigned gw0 = i < 2 ? g0[2 * i] : g1[2 * i - 4], gw1 = i < 2 ? g0[2 * i + 1] : g1[2 * i - 3];
        const float v0 = o[i][0] * rstd * gg[0] * bflo(zw0) * bflo(gw0), v1 = o[i][1] * rstd * gg[1] * bfhi(zw0) * bfhi(gw0);
        const float v2 = o[i][2] * rstd * gg[2] * bflo(zw1) * bflo(gw1), v3 = o[i][3] * rstd * gg[3] * bfhi(zw1) * bfhi(gw1);
        if (first) { am[2 * i] = __builtin_amdgcn_cvt_pkrtz(v0, v1); am[2 * i + 1] = __builtin_amdgcn_cvt_pkrtz(v2, v3); }
        else { res[4 * i] = (float)am[2 * i][0] + v0; res[4 * i + 1] = (float)am[2 * i][1] + v1; res[4 * i + 2] = (float)am[2 * i + 1][0] + v2; res[4 * i + 3] = (float)am[2 * i + 1][1] + v3; } }
}

__device__ __forceinline__ void p2a(const int tid, ldsp lds, const Params& p) {
    const bf16_t* proj = (const bf16_t*)(p.ws + WS_PROJ);
    for (int u = blockIdx.x; u < 256; u += gridDim.x) {
        const int seg = u & 7, h = (u >> 3) & 7, bl = u >> 6;
        if (seg == NSEG - 1) continue;
        const float lg = log1pf(-exp2f(-5.0f - (float)h)) * 1.4426950408889634f;
        f32x4 SA[8], SB[4];
#pragma unroll
        for (int i = 0; i < 8; ++i) SA[i] = (f32x4){0.f, 0.f, 0.f, 0.f};
#pragma unroll
        for (int i = 0; i < 4; ++i) SB[i] = (f32x4){0.f, 0.f, 0.f, 0.f};
        float gs0 = 0.f, gs1 = 0.f;
        const size_t row0 = (size_t)bl * SEQ + (size_t)seg * SEGLEN;
        unsigned hq[8], hg[8], hv[8], rq[4], rk[4], rv[8];
        load_hg<false>(tid, proj + row0 * DIN, h, hq, hg, hv);
        for (int c = 0; c < NCH; ++c) { const bf16_t* P = proj + (row0 + (size_t)c * 64) * DIN;
            load_rt<false>(tid, P, h, rq, rk, rv);
            prep_hg<false>(tid, lds, hq, hg, hv, gs0, gs1); mix_core<128, false>(tid, lds, SA);
            if (c + 1 < NCH) load_hg<false>(tid, P + (size_t)64 * DIN, h, hq, hg, hv);
            prep_rt<false>(tid, lds, rq, rk, rv, lg);       mix_core<64, false>(tid, lds, SB); }
        float* sla = (float*)(p.ws + WS_SLA) + (size_t)u * 16384; float* slb = (float*)(p.ws + WS_SLB) + (size_t)u * 8192; float* da = (float*)(p.ws + WS_DA) + (size_t)u * 128;
#pragma unroll
        for (int i = 0; i < 8; ++i) *(f32x4*)((char*)sla + (unsigned)(tid * 128 + i * 16)) = SA[i];
#pragma unroll
        for (int i = 0; i < 4; ++i) *(f32x4*)((char*)slb + (unsigned)(tid * 64 + i * 16)) = SB[i];
        if (tid < 64) { da[2 * tid] = ex2(gs0); da[2 * tid + 1] = ex2(gs1); }
    }
}
__device__ __forceinline__ void p2b(const int tid, ldsp lds, const Params& p, int half) {
    const bf16_t* proj = (const bf16_t*)(p.ws + WS_PROJ);
    bf16_t* Mo = (bf16_t*)(p.ws + WS_H) + (size_t)half * MH * D;
    const int w = __builtin_amdgcn_readfirstlane(tid >> 6), lane = tid & 63, quad = lane >> 4;
    for (int u = blockIdx.x; u < 256; u += gridDim.x) {
        const int seg = u & 7, h = (u >> 3) & 7, bl = u >> 6;
        const float lg = log1pf(-exp2f(-5.0f - (float)h)) * 1.4426950408889634f;
        const float dB = ex2((float)SEGLEN * lg);
        f32x4 SA[8], SB[4];
#pragma unroll
        for (int i = 0; i < 8; ++i) SA[i] = (f32x4){0.f, 0.f, 0.f, 0.f};
#pragma unroll
        for (int i = 0; i < 4; ++i) SB[i] = (f32x4){0.f, 0.f, 0.f, 0.f};
        for (int s = 0; s < seg; ++s) { const int uu = u - seg + s;
            const float* sla = (const float*)(p.ws + WS_SLA) + (size_t)uu * 16384; const float* slb = (const float*)(p.ws + WS_SLB) + (size_t)uu * 8192;
            const f32x4 d4 = *(const f32x4*)((const float*)(p.ws + WS_DA) + (size_t)uu * 128 + w * 16 + quad * 4);
#pragma unroll
            for (int i = 0; i < 8; ++i) SA[i] = SA[i] * d4 + *(const f32x4*)((const char*)sla + (unsigned)(tid * 128 + i * 16));
#pragma unroll
            for (int i = 0; i < 4; ++i) SB[i] = SB[i] * dB + *(const f32x4*)((const char*)slb + (unsigned)(tid * 64 + i * 16)); }
        float gs0 = 0.f, gs1 = 0.f;
        const size_t row0 = (size_t)bl * SEQ + (size_t)seg * SEGLEN;
        const int t = tid >> 3, c8 = tid & 7;
        if (tid < 256) *(LAS float*)(lds + L_GN + tid * 4) = (tid < 128) ? p.hg_norm_g[h * 128 + tid] : p.ret_norm_g[h * 128 + tid - 128];
        unsigned hq[8], hg[8], hv[8], rq[4], rk[4], rv[8]; u32x4 z0, z1, g0, g1;
        load_hg<true, 1>(tid, proj + row0 * DIN, h, hq, hg, hv);
        for (int c = 0; c < NCH; ++c) { const bf16_t* P = proj + (row0 + (size_t)c * 64) * DIN;
            h16x2 am[8]; float res[16];
            load_hg<true, 2>(tid, P, h, hq, hg, hv);
            prep_hg<true>(tid, lds, hq, hg, hv, gs0, gs1);
            load_rt<true, 1>(tid, P, h, rq, rk, rv); load_gates(tid, P + h * 128, C_HZ, C_GA, z0, z1, g0, g1);
            mix_core<128, true>(tid, lds, SA);
            epi_mix(tid, lds, z0, z1, g0, g1, 0, am, res, true);
            load_rt<true, 2>(tid, P, h, rq, rk, rv);
            prep_rt<true>(tid, lds, rq, rk, rv, lg);
            if (c + 1 < NCH) load_hg<true, 1>(tid, P + (size_t)64 * DIN, h, hq, hg, hv);
            load_gates(tid, P + h * 128, C_RZ, C_GB, z0, z1, g0, g1);
            mix_core<64, true>(tid, lds, SB);
            epi_mix(tid, lds, z0, z1, g0, g1, 512, am, res, false);
            bf16_t* mo = Mo + (row0 + (size_t)c * 64 + t) * D + h * 128 + 16 * c8;
            *(u32x4*)mo = (u32x4){pkbf(res[0], res[1]), pkbf(res[2], res[3]), pkbf(res[4], res[5]), pkbf(res[6], res[7])};
            *(u32x4*)(mo + 8) = (u32x4){pkbf(res[8], res[9]), pkbf(res[10], res[11]), pkbf(res[12], res[13]), pkbf(res[14], res[15])};
        }
    }
}

#ifndef REP_P0A
#define REP_P0A 1
#endif
#ifndef REP_P0B
#define REP_P0B 1
#endif
#ifndef REP_P3
#define REP_P3 1
#endif
#ifndef REP_P1
#define REP_P1 1
#endif
#ifndef REP_P2A
#define REP_P2A 1
#endif
#ifndef REP_P2B
#define REP_P2B 1
#endif
__global__ void __launch_bounds__(512, 2) fwd_megakernel(Params p) {
    extern __shared__ __attribute__((aligned(16))) unsigned char lds_raw[];
    ldsp lds = (ldsp)lds_raw;
    cg::grid_group grid = cg::this_grid();
    const int G = gridDim.x;
    const int wv = __builtin_amdgcn_readfirstlane((int)threadIdx.x >> 6);
#define FRESH_TID() ({ int l_ = (int)__builtin_amdgcn_mbcnt_hi(~0u, __builtin_amdgcn_mbcnt_lo(~0u, 0u)); asm volatile("" : "+v"(l_)); wv * 64 + l_; })
    { const int tid = FRESH_TID(); if (tid == 0) *(LAS u32x4*)(lds + L_XB) = (u32x4){0u, 0u, 0u, 0u}; }
    __syncthreads();
    const XcdBarrier xbar = xcd_barrier_post((unsigned*)(p.ws + WS_BAR), (volatile LAS unsigned*)(lds + L_XB), FRESH_TID() == 0);
#define GSYNC() xcd_barrier(xbar, FRESH_TID() == 0)
    for (int r_ = 0; r_ < REP_P0A; ++r_) {
    for (int j = blockIdx.x; j < 48; j += G) p0_mod(FRESH_TID(), lds, p, j);
    p0_tables(FRESH_TID(), p);
    for (int tI = blockIdx.x; tI < 144 * 16 + 16 * 16; tI += G) {
        if (tI < 144 * 16) { const int nt = tI / 16, kt = tI % 16; p0_transpose(FRESH_TID(), lds, p.w_in, DIN, (bf16_t*)(p.ws + WS_WIN), kt, nt, nt >= C_RQ / 64 && nt < C_RV / 64); }
        else { const int q = tI - 144 * 16; p0_transpose(FRESH_TID(), lds, p.w_out, D, (bf16_t*)(p.ws + WS_WOUT), q % 16, q / 16, false); }
    }
    if (G == 0x7fffffff) grid.sync();
    GSYNC(); }
    for (int r_ = 0; r_ < REP_P0B; ++r_) p0_hnorm(FRESH_TID(), p);
    GSYNC();
    for (int half = 0; half < 2; ++half) {
        for (int r_ = 0; r_ < REP_P1; ++r_) { pg8::Gemm g{(const bf16_t*)(p.ws + WS_H) + (size_t)half * MH * D, (const bf16_t*)(p.ws + WS_WIN), MH, DIN, D};
          pg8::StaticOrder S; S.init(MH, DIN, G, (int)blockIdx.x);
          EpiProj E{(bf16_t*)(p.ws + WS_PROJ), (const float*)(p.ws + WS_LB), (const float*)(p.ws + WS_ROPE)};
          pg8::gemm_phase<EpiProj, pg8::StaticOrder, false>(FRESH_TID(), lds, g, S, E, nullptr); if (r_ + 1 < REP_P1) GSYNC(); }
        GSYNC();
        for (int r_ = 0; r_ < REP_P2A; ++r_) { p2a(FRESH_TID(), lds, p); if (r_ + 1 < REP_P2A) GSYNC(); }
        GSYNC();
        for (int r_ = 0; r_ < REP_P2B; ++r_) { p2b(FRESH_TID(), lds, p, half); if (r_ + 1 < REP_P2B) GSYNC(); }
        GSYNC();
    }
    for (int r_ = 0; r_ < REP_P3; ++r_) { pg8::Gemm g{(const bf16_t*)(p.ws + WS_H), (const bf16_t*)(p.ws + WS_WOUT), MTOT, D, D};
      pg8::StaticOrder S; S.init(MTOT, D, G, (int)blockIdx.x);
      EpiRes E{p.x, p.out, (const float*)(p.ws + WS_MOD)};
      pg8::gemm_phase<EpiRes, pg8::StaticOrder, false>(FRESH_TID(), lds, g, S, E, nullptr); if (r_ + 1 < REP_P3) GSYNC(); }
    GSYNC();
    p4_final(FRESH_TID(), p);
}

extern "C" void kernel_launch(void* const* d_in, const int* in_sizes, int n_in, void* d_out, int out_size, void* d_ws, size_t ws_size, hipStream_t stream) {
    static int grid = 0;
    if (grid == 0) {
        if (n_in != 11 || out_size != MTOT * D || ws_size < WS_END) { fprintf(stderr, "kernel_launch: unexpected shapes (n_in %d out %d ws %zu)\n", n_in, out_size, ws_size); grid = -1; return; }
        int dev = 0, cus = 0, per_cu = 0;
        hipGetDevice(&dev); hipDeviceGetAttribute(&cus, hipDeviceAttributeMultiprocessorCount, dev);
        if (hipFuncSetAttribute((const void*)fwd_megakernel, hipFuncAttributeMaxDynamicSharedMemorySize, LDS_BYTES) != hipSuccess) { fprintf(stderr, "kernel_launch: hipFuncSetAttribute failed\n"); grid = -1; return; }
        if (hipOccupancyMaxActiveBlocksPerMultiprocessor(&per_cu, (const void*)fwd_megakernel, 512, LDS_BYTES) != hipSuccess || per_cu < 1) { fprintf(stderr, "kernel_launch: occupancy query failed (%d)\n", per_cu); per_cu = 1; }
        (void)hipGetLastError();
        grid = cus;
        fprintf(stderr, "kernel_launch: cus %d per_cu %d grid %d\n", cus, per_cu, grid);
    }
    if (grid < 0) return;
    Params p{};
    p.x = (const float*)d_in[0]; p.c = (const float*)d_in[1]; p.norm_g = (const float*)d_in[2]; p.w_ada = (const float*)d_in[3]; p.b_ada = (const float*)d_in[4];
    p.w_in = (const float*)d_in[5]; p.lb_logits = (const float*)d_in[6]; p.hg_norm_g = (const float*)d_in[7]; p.ret_norm_g = (const float*)d_in[8]; p.w_out = (const float*)d_in[9];
    p.final_g = (const float*)d_in[10]; p.out = (float*)d_out; p.ws = (unsigned char*)d_ws;
    if (hipMemsetAsync((char*)d_ws + WS_BAR, 0, XCD_BAR_WORDS * 4, stream) != hipSuccess) { fprintf(stderr, "kernel_launch: memset failed\n"); return; }
    void* args[] = {&p};
    hipError_t e = hipLaunchCooperativeKernel((const void*)fwd_megakernel, dim3(grid), dim3(512), args, LDS_BYTES, stream);
    if (e != hipSuccess) fprintf(stderr, "kernel_launch: cooperative launch failed: %s (grid %d)\n", hipGetErrorString(e), grid);
}
```
